# Optimizing an MI355X kernel written in HIP

```python
import jax, jax.numpy as jnp
from jax import lax
import numpy as np

D_MODEL = 2048
BATCH = 2
SEQ = 4096
DEPTH = 2

N_MIXERS = 2
HEAD_DIM = 128
ATTN_HEADS = D_MODEL // HEAD_DIM
DILATED_GROUPS = ((128, 1), (512, 4), (2048, 16))
N_DIL = len(DILATED_GROUPS)
ROT_DIM = HEAD_DIM // 4
ROPE_THETA = 500000.0
FNET_WIDTH = D_MODEL
FNET_GROUPS = 4
FNET_GROUP_CH = FNET_WIDTH // FNET_GROUPS
N_EXPERT_GROUPS = 4
EXPERTS_PER_GROUP = 8
N_EXPERTS = N_EXPERT_GROUPS * EXPERTS_PER_GROUP
EXPERT_DIM = D_MODEL // 4
TOP_K_FINE = 2
MOE_BLOCK = 128
LN_EPS = 1e-5
NEG_INF = -1e30
DEEPNORM_ALPHA = (2 * DEPTH) ** 0.25
DEEPNORM_BETA = (8 * DEPTH) ** -0.25
N_ATTN_LAYERS = (DEPTH + 1) // 2
N_FNET_LAYERS = DEPTH // 2

kernel_name = "hybrid_dilated_attn_fnet_hier_moe_deepnorm_adaln"


def layer_norm(x, g, b):
    xf = x.astype(jnp.float32)
    mu = jnp.mean(xf, axis=-1, keepdims=True)
    var = jnp.mean(jnp.square(xf - mu), axis=-1, keepdims=True)
    y = (xf - mu) * lax.rsqrt(var + LN_EPS)
    return (y * g.astype(jnp.float32) + b.astype(jnp.float32)).astype(x.dtype)


def adaln(c, w, b):
    m = jax.nn.silu(c) @ w + b
    shift, scale, gate = jnp.split(m, 3, axis=-1)
    return shift[:, None, :], scale[:, None, :], gate[:, None, :]


def rotary_tables(positions, dtype):
    inv_freq = ROPE_THETA ** (-jnp.arange(0, ROT_DIM, 2, dtype=jnp.float32) / ROT_DIM)
    ang = positions.astype(jnp.float32)[..., None] * inv_freq
    return (jnp.cos(ang)[:, :, None, :].astype(dtype),
            jnp.sin(ang)[:, :, None, :].astype(dtype))


def partial_rotary(t, cos, sin):
    half = ROT_DIM // 2
    t1, t2, rest = t[..., :half], t[..., half:ROT_DIM], t[..., ROT_DIM:]
    return jnp.concatenate([t1 * cos - t2 * sin, t2 * cos + t1 * sin, rest], axis=-1)


def stride_split(t, d):
    bsz, s = t.shape[:2]
    rest = t.shape[2:]
    t = jnp.moveaxis(t.reshape(bsz, s // d, d, *rest), 2, 1)
    return t.reshape(bsz * d, s // d, *rest)


def stride_merge(t, bsz, d):
    n, l = t.shape[:2]
    rest = t.shape[2:]
    t = jnp.moveaxis(t.reshape(bsz, d, l, *rest), 1, 2)
    return t.reshape(bsz, l * d, *rest)


def banded_attention(q, k, v, radius):
    n, l, h, dh = q.shape
    blk = radius
    nb = -(-l // blk)
    lp = nb * blk
    qb = jnp.pad(q, ((0, 0), (0, lp - l), (0, 0), (0, 0))).reshape(n, nb, blk, h, dh)

    def windows(t):
        tp = jnp.pad(t, ((0, 0), (blk, lp - l + blk), (0, 0), (0, 0))).reshape(n, nb + 2, blk, h, dh)
        return jnp.concatenate([tp[:, :-2], tp[:, 1:-1], tp[:, 2:]], axis=2)

    kw, vw = windows(k), windows(v)
    s = jnp.einsum('nbqhd,nbkhd->nbhqk', qb, kw, preferred_element_type=jnp.float32) * (dh ** -0.5)
    qpos = jnp.arange(nb)[:, None] * blk + jnp.arange(blk)[None, :]
    kpos = jnp.arange(nb)[:, None] * blk - blk + jnp.arange(3 * blk)[None, :]
    valid = ((jnp.abs(qpos[:, :, None] - kpos[:, None, :]) <= radius)
             & (kpos >= 0)[:, None, :] & (kpos < l)[:, None, :])
    s = jnp.where(valid[None, :, None], s, NEG_INF)
    m = jnp.max(s, axis=-1, keepdims=True)
    p = jnp.exp(s - m)
    den = jnp.sum(p, axis=-1, keepdims=True)
    o = jnp.einsum('nbhqk,nbkhd->nbqhd', p, vw.astype(jnp.float32)) / jnp.swapaxes(den, 2, 3)
    lse = jnp.swapaxes((m + jnp.log(den))[..., 0], 2, 3)
    return o.reshape(n, lp, h, dh)[:, :l], lse.reshape(n, lp, h)[:, :l]


def dilated_attention(h, w_qkv, w_o, cos, sin):
    bsz, s, _ = h.shape
    qkv = (h @ w_qkv).reshape(bsz, s, N_DIL, 3, ATTN_HEADS, HEAD_DIM)
    outs, lses = [], []
    for g, (window, dil) in enumerate(DILATED_GROUPS):
        radius = window // (2 * dil)
        q = partial_rotary(qkv[:, :, g, 0], cos, sin)
        k = partial_rotary(qkv[:, :, g, 1], cos, sin)
        v = qkv[:, :, g, 2]
        o_g, lse_g = banded_attention(stride_split(q, dil), stride_split(k, dil),
                                      stride_split(v, dil), radius)
        outs.append(stride_merge(o_g, bsz, dil))
        lses.append(stride_merge(lse_g, bsz, dil))
    wts = jax.nn.softmax(jnp.stack(lses), axis=0)
    o = jnp.einsum('gbsh,gbshd->bshd', wts, jnp.stack(outs)).astype(h.dtype)
    return o.reshape(bsz, s, ATTN_HEADS * HEAD_DIM) @ w_o


def fourier_mixer(h, w_in, w_out):
    bsz, s, _ = h.shape
    u = (h @ w_in).reshape(bsz, s, FNET_GROUPS, FNET_GROUP_CH).astype(jnp.float32)
    y = jnp.fft.fft2(u, axes=(1, 3), norm='ortho').real
    return y.astype(h.dtype).reshape(bsz, s, FNET_WIDTH) @ w_out


def hier_moe(h, wr1, br1, wr2, br2, w_gate, w_up, w_down):
    bsz, s, d = h.shape
    t = h.reshape(-1, d)
    n_tok = t.shape[0]
    pc = jax.nn.softmax((t @ wr1).astype(jnp.float32) + br1.astype(jnp.float32), axis=-1)
    pg, gi = lax.top_k(pc, 1)
    lf = ((t @ wr2).astype(jnp.float32) + br2.astype(jnp.float32)).reshape(n_tok, N_EXPERT_GROUPS, EXPERTS_PER_GROUP)
    lf_sel = jnp.take_along_axis(lf, gi[:, :, None], axis=1)[:, 0]
    pk, ek = lax.top_k(jax.nn.softmax(lf_sel, axis=-1), TOP_K_FINE)
    gates = pg * (pk / jnp.sum(pk, axis=-1, keepdims=True))
    eid = gi * EXPERTS_PER_GROUP + ek

    tk = n_tok * TOP_K_FINE
    e_flat = eid.reshape(-1)
    g_flat = gates.reshape(-1)
    tok = jnp.arange(tk, dtype=jnp.int32) // TOP_K_FINE
    order = jnp.argsort(e_flat)
    e_s, tok_s, g_s = e_flat[order], tok[order], g_flat[order]
    counts = jnp.bincount(e_flat, length=N_EXPERTS)
    starts = jnp.cumsum(counts) - counts
    padded = (counts + MOE_BLOCK - 1) // MOE_BLOCK * MOE_BLOCK
    pends = jnp.cumsum(padded)
    pstarts = pends - padded
    dest = pstarts[e_s] + (jnp.arange(tk) - starts[e_s])
    n_blocks = -(-tk // MOE_BLOCK) + N_EXPERTS
    n_rows = n_blocks * MOE_BLOCK
    row_tok = jnp.zeros((n_rows,), jnp.int32).at[dest].set(tok_s)
    row_gate = jnp.zeros((n_rows,), t.dtype).at[dest].set(g_s.astype(t.dtype))
    block_e = jnp.clip(jnp.searchsorted(pends, jnp.arange(n_blocks) * MOE_BLOCK, side='right'), 0, N_EXPERTS - 1)

    def run_block(args):
        tok_b, gate_b, e = args
        xb = t[tok_b]
        a = jax.nn.silu(xb @ w_gate[e]) * (xb @ w_up[e])
        return (a @ w_down[e]) * gate_b[:, None]

    ys = lax.map(run_block, (row_tok.reshape(n_blocks, MOE_BLOCK),
                             row_gate.reshape(n_blocks, MOE_BLOCK), block_e))
    out = jnp.zeros_like(t).at[row_tok].add(ys.reshape(n_rows, d))
    return out.reshape(bsz, s, d)


def setup_inputs(seed: int = 0) -> dict:
    key = jax.random.key(seed)
    ks = jax.random.split(key, 20)

    def nrm(k, shape, scale):
        return jax.random.normal(k, shape, jnp.float32) * scale

    hd_total = ATTN_HEADS * HEAD_DIM
    qkv_scale = jnp.array([1.0, 1.0, DEEPNORM_BETA], jnp.float32).reshape(1, 1, 1, 3, 1)
    return {
        "x": nrm(ks[0], (BATCH, SEQ, D_MODEL), 1.0),
        "c": nrm(ks[1], (BATCH, D_MODEL), 1.0),
        "positions": jnp.broadcast_to(jnp.arange(SEQ, dtype=jnp.int32), (BATCH, SEQ)),
        "ada_w": nrm(ks[2], (DEPTH, 2, D_MODEL, 3 * D_MODEL), D_MODEL ** -0.5),
        "ada_b": nrm(ks[3], (DEPTH, 2, 3 * D_MODEL), 0.02),
        "attn_w_qkv": (nrm(ks[4], (N_ATTN_LAYERS, D_MODEL, N_DIL, 3, hd_total), D_MODEL ** -0.5)
                       * qkv_scale).reshape(N_ATTN_LAYERS, D_MODEL, N_DIL * 3 * hd_total),
        "attn_w_o": nrm(ks[5], (N_ATTN_LAYERS, hd_total, D_MODEL), hd_total ** -0.5 * DEEPNORM_BETA),
        "fnet_w_in": nrm(ks[6], (N_FNET_LAYERS, D_MODEL, FNET_WIDTH), D_MODEL ** -0.5 * DEEPNORM_BETA),
        "fnet_w_out": nrm(ks[7], (N_FNET_LAYERS, FNET_WIDTH, D_MODEL), FNET_WIDTH ** -0.5 * DEEPNORM_BETA),
        "ln_g": 1.0 + nrm(ks[8], (DEPTH, 2, D_MODEL), 0.02),
        "ln_b": nrm(ks[9], (DEPTH, 2, D_MODEL), 0.02),
        "router_coarse_w": nrm(ks[10], (DEPTH, D_MODEL, N_EXPERT_GROUPS), D_MODEL ** -0.5),
        "router_coarse_b": nrm(ks[11], (DEPTH, N_EXPERT_GROUPS), 0.01),
        "router_fine_w": nrm(ks[12], (DEPTH, D_MODEL, N_EXPERTS), D_MODEL ** -0.5),
        "router_fine_b": nrm(ks[13], (DEPTH, N_EXPERTS), 0.01),
        "expert_w_gate": nrm(ks[14], (DEPTH, N_EXPERTS, D_MODEL, EXPERT_DIM), D_MODEL ** -0.5 * DEEPNORM_BETA),
        "expert_w_up": nrm(ks[15], (DEPTH, N_EXPERTS, D_MODEL, EXPERT_DIM), D_MODEL ** -0.5 * DEEPNORM_BETA),
        "expert_w_down": nrm(ks[16], (DEPTH, N_EXPERTS, EXPERT_DIM, D_MODEL), EXPERT_DIM ** -0.5 * DEEPNORM_BETA),
    }


def reference(x, c, positions, ada_w, ada_b, attn_w_qkv, attn_w_o, fnet_w_in, fnet_w_out,
              ln_g, ln_b, router_coarse_w, router_coarse_b, router_fine_w, router_fine_b,
              expert_w_gate, expert_w_up, expert_w_down):
    cos, sin = rotary_tables(positions, x.dtype)
    for i in range(DEPTH):
        j = i // N_MIXERS
        shift, scale, gate = adaln(c, ada_w[i, 0], ada_b[i, 0])
        h = x * (1.0 + scale) + shift
        if i % N_MIXERS == 0:
            y = dilated_attention(h, attn_w_qkv[j], attn_w_o[j], cos, sin)
        else:
            y = fourier_mixer(h, fnet_w_in[j], fnet_w_out[j])
        x = layer_norm(DEEPNORM_ALPHA * x + gate * y, ln_g[i, 0], ln_b[i, 0])
        shift, scale, gate = adaln(c, ada_w[i, 1], ada_b[i, 1])
        h = x * (1.0 + scale) + shift
        y = hier_moe(h, router_coarse_w[i], router_coarse_b[i], router_fine_w[i], router_fine_b[i],
                     expert_w_gate[i], expert_w_up[i], expert_w_down[i])
        x = layer_norm(DEEPNORM_ALPHA * x + gate * y, ln_g[i, 1], ln_b[i, 1])
    return x
```

```cpp
#include <hip/hip_runtime.h>
#include <stdint.h>

namespace {
constexpr int D = 2048, NB = 2, SEQ = 4096, T = NB * SEQ, NQKV = 18432, NE = 32, ED = 512;
constexpr float ALPHA = 1.41421356237309515f;
constexpr float LN_EPS = 1e-5f;

__global__ void k_adaln(const float* __restrict__ c, const float* __restrict__ ada_w, const float* __restrict__ ada_b, float* __restrict__ mod) {
    __shared__ float sc[2][2048];
    const int col = blockIdx.x * 256 + threadIdx.x, idx = blockIdx.y;
    for (int i = threadIdx.x; i < 4096; i += 256) { const float v = c[i]; sc[i >> 11][i & 2047] = v / (1.f + expf(-v)); }
    __syncthreads();
    const float* w = ada_w + (size_t)idx * 2048 * 6144;
    float a0 = 0.f, a1 = 0.f;
    for (int k = 0; k < 2048; ++k) { const float wv = w[(size_t)k * 6144 + col]; a0 += sc[0][k] * wv; a1 += sc[1][k] * wv; }
    const float bb = ada_b[idx * 6144 + col];
    mod[(idx * 2 + 0) * 6144 + col] = a0 + bb; mod[(idx * 2 + 1) * 6144 + col] = a1 + bb;
}
__global__ void k_tables(const int* __restrict__ pos, float* __restrict__ rot, float* __restrict__ tab4096, float* __restrict__ tab512) {
    const int i = blockIdx.x * 256 + threadIdx.x;
    if (i < T * 16) {
        const int t = i >> 4, j = i & 15;
        const float invf = (float)pow(500000.0, -(double)j / 16.0);
        const float ang = (float)pos[t] * invf;
        double r = (double)ang * 0.31830988618379067154;
        r -= 2.0 * rint(r * 0.5);
        float s, c; sincospif((float)r, &s, &c);
        rot[t * 32 + j] = c; rot[t * 32 + 16 + j] = s;
    }
    if (i < 4096) { float s, c; sincospif((float)i / 2048.0f, &s, &c); tab4096[i] = c; tab4096[4096 + i] = s; }
    if (i < 512) { float s, c; sincospif((float)i / 256.0f, &s, &c); tab512[i] = c; tab512[512 + i] = s; }
}
__global__ void k_modulate(const float* __restrict__ x, const float* __restrict__ mod, float* __restrict__ h) {
    const size_t i = (size_t)blockIdx.x * 256 + threadIdx.x;
    const size_t e = i * 4; const int t = (int)(e / D), d = (int)(e % D), b = t / SEQ;
    const float4 xv = *(const float4*)(x + e);
    const float4 sh = *(const float4*)(mod + b * 6144 + d), sc = *(const float4*)(mod + b * 6144 + 2048 + d);
    float4 o; o.x = xv.x * (1.f + sc.x) + sh.x; o.y = xv.y * (1.f + sc.y) + sh.y; o.z = xv.z * (1.f + sc.z) + sh.z; o.w = xv.w * (1.f + sc.w) + sh.w;
    *(float4*)(h + e) = o;
}
__global__ void k_rotary(float* __restrict__ qkv, const float* __restrict__ rot) {
    const size_t id = (size_t)blockIdx.x * 256 + threadIdx.x;
    const int i = (int)(id & 15), head = (int)((id >> 4) & 15), which = (int)((id >> 8) & 1), g = (int)((id >> 9) % 3), t = (int)(id / (512 * 3));
    float* p = qkv + (size_t)t * NQKV + g * 6144 + which * 2048 + head * 128;
    const float c = rot[t * 32 + i], s = rot[t * 32 + 16 + i];
    const float a = p[i], b = p[i + 16];
    p[i] = a * c - b * s; p[i + 16] = b * c + a * s;
}
__global__ void k_attn(const float* __restrict__ qkv, float* __restrict__ o) {
    const int lane = threadIdx.x & 63, w = threadIdx.x >> 6;
    const int t = blockIdx.x >> 2, head = (blockIdx.x & 3) * 4 + w, b = t / SEQ, s = t % SEQ;
    float m = -1e30f, l = 0.f, a0 = 0.f, a1 = 0.f;
    for (int g = 0; g < 3; ++g) {
        const int dil = g == 0 ? 1 : (g == 1 ? 4 : 16);
        const float2 q = *(const float2*)(qkv + (size_t)t * NQKV + g * 6144 + head * 128 + lane * 2);
        for (int dl = -64; dl <= 64; ++dl) {
            const int s2 = s + dl * dil; if (s2 < 0 || s2 >= SEQ) continue;
            const float* base = qkv + (size_t)(b * SEQ + s2) * NQKV + g * 6144 + head * 128 + lane * 2;
            const float2 kv = *(const float2*)(base + 2048), vv = *(const float2*)(base + 4096);
            float p = q.x * kv.x + q.y * kv.y;
#pragma unroll
            for (int o2 = 32; o2 >= 1; o2 >>= 1) p += __shfl_xor(p, o2);
            p *= 0.08838834764831845f;
            const float mn = fmaxf(m, p), corr = expf(m - mn), e = expf(p - mn);
            l = l * corr + e; a0 = a0 * corr + e * vv.x; a1 = a1 * corr + e * vv.y; m = mn;
        }
    }
    const float inv = 1.f / l;
    *(float2*)(o + (size_t)t * D + head * 128 + lane * 2) = make_float2(a0 * inv, a1 * inv);
}
__global__ void k_ln(const float* __restrict__ xin, const float* __restrict__ y0, const float* __restrict__ y1, const float* __restrict__ mod,
                     const float* __restrict__ lg, const float* __restrict__ lb, float* __restrict__ out) {
    __shared__ float red[8];
    const int t = blockIdx.x, b = t / SEQ, tid = threadIdx.x;
    float z[8]; float sum = 0.f;
#pragma unroll
    for (int j = 0; j < 8; ++j) { const int d = tid + j * 256; const size_t e = (size_t)t * D + d;
        float y = y0[e]; if (y1) y += y1[e];
        z[j] = ALPHA * xin[e] + mod[b * 6144 + 4096 + d] * y; sum += z[j]; }
#pragma unroll
    for (int o2 = 32; o2 >= 1; o2 >>= 1) sum += __shfl_xor(sum, o2);
    if ((tid & 63) == 0) red[tid >> 6] = sum;
    __syncthreads();
    const float mean = (red[0] + red[1] + red[2] + red[3]) * (1.f / D);
    float q = 0.f;
#pragma unroll
    for (int j = 0; j < 8; ++j) { const float dd = z[j] - mean; q += dd * dd; }
#pragma unroll
    for (int o2 = 32; o2 >= 1; o2 >>= 1) q += __shfl_xor(q, o2);
    if ((tid & 63) == 0) red[4 + (tid >> 6)] = q;
    __syncthreads();
    const float rstd = 1.0f / sqrtf((red[4] + red[5] + red[6] + red[7]) * (1.f / D) + LN_EPS);
#pragma unroll
    for (int j = 0; j < 8; ++j) { const int d = tid + j * 256; out[(size_t)t * D + d] = (z[j] - mean) * rstd * lg[d] + lb[d]; }
}
__global__ void k_router(const float* __restrict__ h, const float* __restrict__ wr1, const float* __restrict__ br1, const float* __restrict__ wr2, const float* __restrict__ br2,
                         int* __restrict__ eid, float* __restrict__ gw) {
    const int lane = threadIdx.x & 63, t = blockIdx.x * 4 + (threadIdx.x >> 6);
    float acc[36];
#pragma unroll
    for (int j = 0; j < 36; ++j) acc[j] = 0.f;
    for (int k = lane; k < D; k += 64) {
        const float hv = h[(size_t)t * D + k];
        const float4 c4 = *(const float4*)(wr1 + k * 4);
        acc[0] += hv * c4.x; acc[1] += hv * c4.y; acc[2] += hv * c4.z; acc[3] += hv * c4.w;
#pragma unroll
        for (int j = 0; j < 8; ++j) { const float4 f4 = *(const float4*)(wr2 + k * 32 + j * 4);
            acc[4 + j * 4] += hv * f4.x; acc[5 + j * 4] += hv * f4.y; acc[6 + j * 4] += hv * f4.z; acc[7 + j * 4] += hv * f4.w; }
    }
#pragma unroll
    for (int j = 0; j < 36; ++j) {
#pragma unroll
        for (int o2 = 32; o2 >= 1; o2 >>= 1) acc[j] += __shfl_xor(acc[j], o2);
    }
    float lc[4]; float mx = -1e30f; int gi = 0;
#pragma unroll
    for (int j = 0; j < 4; ++j) { lc[j] = acc[j] + br1[j]; if (lc[j] > mx) { mx = lc[j]; gi = j; } }
    float den = 0.f;
#pragma unroll
    for (int j = 0; j < 4; ++j) den += expf(lc[j] - mx);
    const float pg = 1.f / den;
    float lf[8];
#pragma unroll
    for (int j = 0; j < 8; ++j) { const float v = gi == 0 ? acc[4 + j] : (gi == 1 ? acc[12 + j] : (gi == 2 ? acc[20 + j] : acc[28 + j])); lf[j] = v + br2[gi * 8 + j]; }
    float v1 = -1e30f, v2 = -1e30f; int i1 = 0, i2 = 0;
#pragma unroll
    for (int j = 0; j < 8; ++j) { if (lf[j] > v1) { v2 = v1; i2 = i1; v1 = lf[j]; i1 = j; } else if (lf[j] > v2) { v2 = lf[j]; i2 = j; } }
    const float e2 = expf(v2 - v1), g1 = pg / (1.f + e2), g2 = pg * e2 / (1.f + e2);
    if (lane == 0) { eid[t * 2] = gi * 8 + i1; eid[t * 2 + 1] = gi * 8 + i2; gw[t * 2] = g1; gw[t * 2 + 1] = g2; }
}
__global__ void k_assign(const int* __restrict__ eid, int* __restrict__ cnt, int* __restrict__ pos) { const int a = blockIdx.x * 256 + threadIdx.x; pos[a] = atomicAdd(&cnt[eid[a]], 1); }
__global__ void k_prefix(const int* __restrict__ cnt, int* __restrict__ off) { if (threadIdx.x == 0) { int s = 0; for (int e = 0; e < NE; ++e) { off[e] = s; s += cnt[e]; } } }
__global__ void k_fill(const int* __restrict__ eid, const int* __restrict__ off, const int* __restrict__ pos, int* __restrict__ list) { const int a = blockIdx.x * 256 + threadIdx.x; list[off[eid[a]] + pos[a]] = a; }

template <class AL, class BL, class EP>
__global__ __launch_bounds__(256) void k_sgemm(long long Kll, AL al, BL bl, EP ep) {
    const int K = (int)Kll;
    __shared__ float As[8][132]; __shared__ float Bs[8][132];
    const int tid = threadIdx.x, bm = blockIdx.y * 128, bn = blockIdx.x * 128, z = blockIdx.z;
    if (!al.tile_ok(z, bm)) return;
    const int ty = tid >> 4, tx = tid & 15;
    float acc[8][8];
#pragma unroll
    for (int i = 0; i < 8; ++i)
#pragma unroll
        for (int j = 0; j < 8; ++j) acc[i][j] = 0.f;
    for (int k0 = 0; k0 < K; k0 += 8) {
        { const int m = tid >> 1, kk = (tid & 1) * 4;
#pragma unroll
          for (int j = 0; j < 4; ++j) As[kk + j][m] = al(z, bm + m, k0 + kk + j); }
        { const int kk = tid >> 5, n = (tid & 31) * 4;
#pragma unroll
          for (int j = 0; j < 4; ++j) Bs[kk][n + j] = bl(z, k0 + kk, bn + n + j); }
        __syncthreads();
#pragma unroll
        for (int kk = 0; kk < 8; ++kk) {
            float a[8], b[8];
#pragma unroll
            for (int i = 0; i < 8; ++i) { a[i] = As[kk][ty * 8 + i]; b[i] = Bs[kk][tx * 8 + i]; }
#pragma unroll
            for (int i = 0; i < 8; ++i)
#pragma unroll
                for (int j = 0; j < 8; ++j) acc[i][j] += a[i] * b[j];
        }
        __syncthreads();
    }
#pragma unroll
    for (int i = 0; i < 8; ++i)
#pragma unroll
        for (int j = 0; j < 8; ++j) ep(z, bm + ty * 8 + i, bn + tx * 8 + j, acc[i][j]);
}
struct ALPlain { const float* A; int lda; int pad; __device__ bool tile_ok(int, int) const { return true; } __device__ float operator()(int, int m, int k) const { return A[(size_t)m * lda + k]; } };
struct BLPlain { const float* B; size_t ldb; size_t zs; __device__ float operator()(int z, int k, int n) const { return B[z * zs + (size_t)k * ldb + n]; } };
struct EPStore { float* C; int ldc; int pad; __device__ void operator()(int, int m, int n, float v) const { C[(size_t)m * ldc + n] = v; } };
struct ALGather { const float* A; const int* list; const int* off; const int* cnt;
    __device__ bool tile_ok(int z, int bm) const { return bm < cnt[z]; }
    __device__ float operator()(int z, int m, int k) const { if (m >= cnt[z]) return 0.f; const int tok = list[off[z] + m] >> 1; return A[(size_t)tok * D + k]; } };
struct ALCompact { const float* A; const int* off; const int* cnt;
    __device__ bool tile_ok(int z, int bm) const { return bm < cnt[z]; }
    __device__ float operator()(int z, int m, int k) const { if (m >= cnt[z]) return 0.f; return A[(size_t)(off[z] + m) * ED + k]; } };
struct EPCompact { float* C; const int* off; const int* cnt; __device__ void operator()(int z, int m, int n, float v) const { if (m < cnt[z]) C[(size_t)(off[z] + m) * ED + n] = v; } };
struct EPAct { const float* G; float* act; const int* off; const int* cnt;
    __device__ void operator()(int z, int m, int n, float v) const { if (m < cnt[z]) { const size_t e = (size_t)(off[z] + m) * ED + n; const float g = G[e]; act[e] = g / (1.f + expf(-g)) * v; } } };
struct EPDown { float* ybuf; const int* list; const float* gw; const int* off; const int* cnt;
    __device__ void operator()(int z, int m, int n, float v) const { if (m < cnt[z]) { const int a = list[off[z] + m]; ybuf[(size_t)(a & 1) * T * D + (size_t)(a >> 1) * D + n] = v * gw[a]; } } };
struct BLDft512 { const float* tab; __device__ float operator()(int, int k, int n) const { return n < 512 ? tab[(k * n) & 511] : tab[512 + ((k * (n - 512)) & 511)]; } };
struct ALDft4096 { const float* tab; __device__ bool tile_ok(int, int) const { return true; }
    __device__ float operator()(int, int m, int k) const { return k < 4096 ? tab[(m * k) & 4095] : -tab[4096 + ((m * (k - 4096)) & 4095)]; } };
struct BLSeq { const float* AB; __device__ float operator()(int z, int k, int n) const { const int g = n >> 9, c = n & 511; const int s = k & 4095;
    return AB[((size_t)(z * SEQ + s) * 4 + g) * 1024 + (k < 4096 ? 0 : 512) + c]; } };
struct EPSeq { float* Y; float scale; int pad; __device__ void operator()(int z, int m, int n, float v) const { Y[(size_t)(z * SEQ + m) * D + n] = v * scale; } };

template <class AL, class BL, class EP> void sgemm(hipStream_t st, int Mtiles, int N, int K, int Z, AL al, BL bl, EP ep) {
    hipLaunchKernelGGL((k_sgemm<AL, BL, EP>), dim3(N / 128, Mtiles, Z), dim3(256), 0, st, (long long)K, al, bl, ep);
}
}

extern "C" void kernel_launch(void* const* d_in, const int* in_sizes, int n_in, void* d_out, int out_size, void* d_ws, size_t ws_size, hipStream_t stream) {
    const float* x = (const float*)d_in[0]; const float* c = (const float*)d_in[1]; const int* positions = (const int*)d_in[2];
    const float* ada_w = (const float*)d_in[3]; const float* ada_b = (const float*)d_in[4];
    const float* w_qkv = (const float*)d_in[5]; const float* w_o = (const float*)d_in[6];
    const float* w_in = (const float*)d_in[7]; const float* w_out = (const float*)d_in[8];
    const float* ln_g = (const float*)d_in[9]; const float* ln_b = (const float*)d_in[10];
    const float* rc_w = (const float*)d_in[11]; const float* rc_b = (const float*)d_in[12];
    const float* rf_w = (const float*)d_in[13]; const float* rf_b = (const float*)d_in[14];
    const float* e_gate = (const float*)d_in[15]; const float* e_up = (const float*)d_in[16]; const float* e_down = (const float*)d_in[17];
    float* out = (float*)d_out;
    char* ws = (char*)d_ws; size_t o = 0;
    auto take = [&](size_t bytes) { char* p = ws + o; o += (bytes + 255) & ~(size_t)255; return p; };
    int* cnt = (int*)take(2 * NE * 4);
    float* mod = (float*)take(4 * 2 * 6144 * 4);
    float* rot = (float*)take((size_t)T * 32 * 4);
    float* tab4096 = (float*)take(8192 * 4); float* tab512 = (float*)take(1024 * 4);
    int* off = (int*)take(NE * 4); int* pos = (int*)take(2 * T * 4); int* list = (int*)take(2 * T * 4); int* eid = (int*)take(2 * T * 4); float* gw = (float*)take(2 * T * 4);
    const size_t TD = (size_t)T * D * 4;
    float* buf0 = (float*)take(TD); float* buf1 = (float*)take(TD); float* buf2 = (float*)take(TD); float* buf3 = (float*)take(TD); float* buf4 = (float*)take(TD); float* buf5 = (float*)take(TD);
    float* R1 = (float*)take((size_t)T * NQKV * 4);
    (void)in_sizes; (void)n_in; (void)out_size; (void)ws_size;

    (void)hipMemsetAsync(cnt, 0, 2 * NE * 4, stream);
    hipLaunchKernelGGL(k_adaln, dim3(6144 / 256, 4), dim3(256), 0, stream, c, ada_w, ada_b, mod);
    hipLaunchKernelGGL(k_tables, dim3(T * 16 / 256), dim3(256), 0, stream, positions, rot, tab4096, tab512);

    auto moe = [&](int layer, const float* xin, float* xout) {
        const float* modp = mod + (layer * 2 + 1) * 2 * 6144;
        float* h = buf0; float* G = R1; float* act = R1 + (size_t)2 * T * ED; float* ybuf = R1 + (size_t)4 * T * ED;
        int* cn = cnt + layer * NE;
        hipLaunchKernelGGL(k_modulate, dim3(T * D / 4 / 256), dim3(256), 0, stream, xin, modp, h);
        hipLaunchKernelGGL(k_router, dim3(T / 4), dim3(256), 0, stream, h, rc_w + (size_t)layer * D * 4, rc_b + layer * 4, rf_w + (size_t)layer * D * 32, rf_b + layer * 32, eid, gw);
        hipLaunchKernelGGL(k_assign, dim3(2 * T / 256), dim3(256), 0, stream, eid, cn, pos);
        hipLaunchKernelGGL(k_prefix, dim3(1), dim3(64), 0, stream, cn, off);
        hipLaunchKernelGGL(k_fill, dim3(2 * T / 256), dim3(256), 0, stream, eid, off, pos, list);
        const size_t wz = (size_t)D * ED;
        sgemm(stream, T / 128, ED, D, NE, ALGather{h, list, off, cn}, BLPlain{e_gate + (size_t)layer * NE * wz, ED, wz}, EPCompact{G, off, cn});
        sgemm(stream, T / 128, ED, D, NE, ALGather{h, list, off, cn}, BLPlain{e_up + (size_t)layer * NE * wz, ED, wz}, EPAct{G, act, off, cn});
        sgemm(stream, T / 128, D, ED, NE, ALCompact{act, off, cn}, BLPlain{e_down + (size_t)layer * NE * wz, D, wz}, EPDown{ybuf, list, gw, off, cn});
        hipLaunchKernelGGL(k_ln, dim3(T), dim3(256), 0, stream, xin, ybuf, ybuf + (size_t)T * D, modp, ln_g + (layer * 2 + 1) * D, ln_b + (layer * 2 + 1) * D, xout);
    };

    hipLaunchKernelGGL(k_modulate, dim3(T * D / 4 / 256), dim3(256), 0, stream, x, mod, buf0);
    sgemm(stream, T / 128, NQKV, D, 1, ALPlain{buf0, D}, BLPlain{w_qkv, NQKV, 0}, EPStore{R1, NQKV});
    hipLaunchKernelGGL(k_rotary, dim3(T * 3 * 512 / 256), dim3(256), 0, stream, R1, rot);
    hipLaunchKernelGGL(k_attn, dim3(T * 4), dim3(256), 0, stream, R1, buf1);
    sgemm(stream, T / 128, D, D, 1, ALPlain{buf1, D}, BLPlain{w_o, D, 0}, EPStore{buf2, D});
    hipLaunchKernelGGL(k_ln, dim3(T), dim3(256), 0, stream, x, buf2, (const float*)nullptr, mod, ln_g, ln_b, buf3);
    moe(0, buf3, buf4);
    const float* mod10 = mod + 2 * 2 * 6144;
    hipLaunchKernelGGL(k_modulate, dim3(T * D / 4 / 256), dim3(256), 0, stream, buf4, mod10, buf0);
    sgemm(stream, T / 128, D, D, 1, ALPlain{buf0, D}, BLPlain{w_in, D, 0}, EPStore{buf1, D});
    sgemm(stream, T * 4 / 128, 1024, 512, 1, ALPlain{buf1, 512}, BLDft512{tab512}, EPStore{R1, 1024});
    sgemm(stream, SEQ / 128, D, 2 * SEQ, NB, ALDft4096{tab4096}, BLSeq{R1}, EPSeq{buf2, 1.0f / sqrtf(4096.f * 512.f)});
    sgemm(stream, T / 128, D, D, 1, ALPlain{buf2, D}, BLPlain{w_out, D, 0}, EPStore{buf5, D});
    hipLaunchKernelGGL(k_ln, dim3(T), dim3(256), 0, stream, buf4, buf5, (const float*)nullptr, mod10, ln_g + 2 * D, ln_b + 2 * D, buf3);
    moe(1, buf3, out);
}
```

```cpp
#include <hip/hip_runtime.h>
#include <stdint.h>

namespace {
constexpr int D = 2048, NB = 2, SEQ = 4096, T = NB * SEQ, NQKV = 18432, NE = 32, ED = 512;
constexpr float ALPHA = 1.41421356237309515f;
constexpr float LN_EPS = 1e-5f;

#define LAS __attribute__((address_space(3)))
typedef unsigned short bf16_t;
typedef short bf16x8 __attribute__((ext_vector_type(8)));
typedef float f32x4 __attribute__((ext_vector_type(4)));
typedef float f32x16 __attribute__((ext_vector_type(16)));
typedef unsigned u32x4 __attribute__((ext_vector_type(4)));
typedef unsigned u32x2 __attribute__((ext_vector_type(2)));

constexpr float QSCALE = 0.08838834764831845f * 1.4426950408889634f;
constexpr int NTHR = 512;
constexpr int LDS_BYTES = 147456;
constexpr int LDS_MISC = 131072;

constexpr size_t MB = 1024 * 1024;
constexpr size_t WS_CTL = 0;
constexpr size_t CTL_BYTES = 32768;
constexpr size_t WS_MOD = WS_CTL + CTL_BYTES;
constexpr size_t WS_ROT = WS_MOD + 196608;
constexpr size_t WS_LSE = WS_ROT + 1 * MB;
constexpr size_t WS_EID = WS_LSE + 1536 * 1024;
constexpr size_t WS_GW = WS_EID + 65536;
constexpr size_t WS_LIST = WS_GW + 65536;
constexpr size_t WS_DC = WS_LIST + 1 * MB;
constexpr size_t WS_WQKV = WS_DC + 1 * MB;
constexpr size_t WS_WO = WS_WQKV + (size_t)18432 * 2048 * 2;
constexpr size_t WS_WIN = WS_WO + 8 * MB;
constexpr size_t WS_WOUT = WS_WIN + 8 * MB;
constexpr size_t WS_WGU = WS_WOUT + 8 * MB;
constexpr size_t WS_WD = WS_WGU + 256 * MB;
constexpr size_t WS_H = WS_WD + 128 * MB;
constexpr size_t WS_O = WS_H + 32 * MB;
constexpr size_t WS_QF = WS_O + 32 * MB;
constexpr size_t WS_KF = WS_QF + 96 * MB;
constexpr size_t WS_VF = WS_KF + 96 * MB;
constexpr size_t WS_OG = WS_VF + 96 * MB;
constexpr size_t WS_FAST_END = WS_OG + 96 * MB;

constexpr int CW_BAR = 0;
constexpr int CW_CNT = 4096;

__device__ __forceinline__ unsigned pack_bf16(float lo, float hi) { unsigned r; asm("v_cvt_pk_bf16_f32 %0, %1, %2" : "=v"(r) : "v"(lo), "v"(hi)); return r; }
__device__ __forceinline__ float bf16_to_f32(bf16_t v) { return __uint_as_float(((unsigned)v) << 16); }
__device__ __forceinline__ int pi32(int x) { return (x & ~12) | ((x & 4) << 1) | ((x & 8) >> 1); }

__device__ __forceinline__ size_t tile_block(int g, int b, int head, int s, int& jo) {
    const int sh = g * 2;
    const int r = s & ((1 << sh) - 1), j = s >> sh, nbr = 128 >> sh;
    jo = j & 31;
    return (size_t)(((g * 2 + b) * 16 + head) * 128 + r * nbr + (j >> 5));
}
__device__ __forceinline__ size_t q_index(int g, int b, int head, int s, int d) { int jo; const size_t blk = tile_block(g, b, head, s, jo); const int c = d >> 3; return ((blk * 8 + (c >> 1)) * 64 + (c & 1) * 32 + jo) * 8 + (d & 7); }
__device__ __forceinline__ size_t k_index(int g, int b, int head, int s, int d) { int jo; const size_t blk = tile_block(g, b, head, s, jo); const int c = d >> 3; return ((blk * 8 + (c >> 1)) * 64 + (c & 1) * 32 + pi32(jo)) * 8 + (d & 7); }
__device__ __forceinline__ size_t v_index(int g, int b, int head, int s, int d) { int jo; const size_t blk = tile_block(g, b, head, s, jo); return ((blk * 8 + (d >> 5) * 2 + (jo >> 4)) * 64 + ((jo >> 3) & 1) * 32 + (d & 31)) * 8 + (jo & 7); }

#define XB_TMO      128
#define XB_XCNT(j)  (256  + 64 * (j))
#define XB_XSUB(j)  (1280 + 64 * (j))
#define XB_XGEN(j)  (2304 + 64 * (j))
#define XB_TOP      3328
#define XB_TOPGEN   3392
#define XCD_BAR_WORDS 3456
#define XB_SPIN_CAP (1u << 18)
__device__ __forceinline__ unsigned xb_ld(unsigned* p)              { return __hip_atomic_load(p, __ATOMIC_RELAXED, __HIP_MEMORY_SCOPE_AGENT); }
__device__ __forceinline__ unsigned xb_add(unsigned* p, unsigned v) { return __hip_atomic_fetch_add(p, v, __ATOMIC_RELAXED, __HIP_MEMORY_SCOPE_AGENT); }
__device__ __forceinline__ unsigned xb_xcc_id() { return (unsigned)__builtin_amdgcn_s_getreg((3 << 11) | 20) & 0xFu; }
#define XB_SPIN(cond, bar) do { unsigned _sp = 0; while (cond) { __builtin_amdgcn_s_sleep(1); \
    if ((++_sp & 255u) == 0u) { if (xb_ld(&(bar)[XB_TMO])) break; if (_sp > XB_SPIN_CAP) { atomicAdd(&(bar)[XB_TMO], 1u); break; } } } } while (0)
struct XcdBarrier { unsigned* bar; unsigned x; volatile LAS unsigned* st; };
__device__ __forceinline__ XcdBarrier xcd_barrier_post(unsigned* bar, volatile LAS unsigned* st) {
    XcdBarrier b; b.bar = bar; b.x = xb_xcc_id(); b.st = st;
    if (threadIdx.x == 0) (void)xb_add(&bar[XB_XCNT(b.x)], 1u);
    return b;
}
__device__ __forceinline__ void xcd_barrier_complete(unsigned* bar, unsigned x, unsigned& nloc, unsigned& nx) {
    const unsigned G = gridDim.x * gridDim.y * gridDim.z;
    unsigned sum, cnt, mine, sp = 0u;
    for (;;) {
        sum = 0u; cnt = 0u; mine = 0u;
#pragma unroll
        for (unsigned j = 0; j < 16; ++j) { const unsigned c = xb_ld(&bar[XB_XCNT(j)]); sum += c; cnt += (c > 0u) ? 1u : 0u; mine = (j == x) ? c : mine; }
        if (sum == G) break;
        __builtin_amdgcn_s_sleep(1);
        if ((++sp & 255u) == 0u) { if (xb_ld(&bar[XB_TMO])) break; if (sp > XB_SPIN_CAP) { atomicAdd(&bar[XB_TMO], 1u); break; } }
    }
    nloc = mine > 0u ? mine : 1u; nx = cnt > 0u ? cnt : 1u;
}
__device__ __forceinline__ void xcd_barrier(const XcdBarrier& b) {
    asm volatile("s_waitcnt vmcnt(0)" ::: "memory");
    __syncthreads();
    if (threadIdx.x == 0) {
        unsigned* bar = b.bar;
        __builtin_amdgcn_s_waitcnt(0);
        unsigned nloc = b.st[0], nx = b.st[1];
        if (nloc == 0u) { xcd_barrier_complete(bar, b.x, nloc, nx); b.st[0] = nloc; b.st[1] = nx; }
        const unsigned old = xb_add(&bar[XB_XSUB(b.x)], 1u);
        const unsigned gen = old / nloc;
        if (old + 1u == (gen + 1u) * nloc) {
            __builtin_amdgcn_fence(__ATOMIC_RELEASE, "agent");
            asm volatile("s_waitcnt vmcnt(0)" ::: "memory");
            const unsigned og = xb_add(&bar[XB_TOP], 1u);
            const unsigned tg = og / nx;
            if (og + 1u == (tg + 1u) * nx) xb_add(&bar[XB_TOPGEN], 1u);
            else XB_SPIN(xb_ld(&bar[XB_TOPGEN]) == tg, bar);
            __builtin_amdgcn_fence(__ATOMIC_ACQUIRE, "agent");
            xb_add(&bar[XB_XGEN(b.x)], 1u);
            asm volatile("s_waitcnt vmcnt(0)" ::: "memory");
        } else {
            XB_SPIN(xb_ld(&bar[XB_XGEN(b.x)]) == gen, bar);
            __builtin_amdgcn_fence(__ATOMIC_ACQUIRE, "agent");
            asm volatile("s_waitcnt vmcnt(0)" ::: "memory");
        }
    }
    __syncthreads();
}

namespace pg8 {
constexpr int BM = 256, BK = 64, HALF = 128, HTB = HALF * BK * 2, STAGE_BYTES = 8 * HTB, NXCD = 8, WGM = 8;
__host__ __device__ __forceinline__ int lds_byte(int r, int c) { const int st = (r >> 4) * 2 + (c >> 5), rr = r & 15, cc = c & 31, ob = rr * 64 + cc * 2; return st * 1024 + (ob ^ (((ob >> 9) & 1) << 5)); }
__host__ __device__ __forceinline__ void stage_rc(int b, int& R, int& C) { const int st = b / 1024, sb = b % 1024, swz = sb ^ (((sb >> 9) & 1) << 5); R = (st >> 1) * 16 + swz / 64; C = (st & 1) * 32 + (swz % 64) / 2; }
__host__ __device__ __forceinline__ int perm32(int rho) { const int n = rho >> 4, i = rho & 15; return 8 * (i >> 2) + 4 * n + (i & 3); }

struct Unit { int pm, pn, e, row0; };

struct PlainSched {
    const bf16_t* A; const bf16_t* Bt; int K, ldb; int nM, nN, nwg, G, c;
    __device__ void init(const bf16_t* A_, const bf16_t* Bt_, int M, int N, int K_, int G_, int c_) { A = A_; Bt = Bt_; K = K_; ldb = K_; nM = M / BM; nN = N / BM; nwg = nM * nN; G = G_; c = c_; }
    __device__ bool next(int i, Unit& u) const {
        const long L = (long)i * G + c; if (L >= nwg) return false;
        int wgid = (int)L; { const int q = nwg / NXCD, r = nwg % NXCD, xcd = wgid % NXCD, off = wgid / NXCD; wgid = (xcd < r ? xcd * (q + 1) : r * (q + 1) + (xcd - r) * q) + off; }
        const int nig = WGM * nN, gid = wgid / nig, fm = gid * WGM, gsz = (nM - fm) < WGM ? (nM - fm) : WGM;
        u.pm = fm + ((wgid % nig) % gsz); u.pn = (wgid % nig) / gsz; u.e = 0; u.row0 = 0; return true;
    }
    __device__ __forceinline__ const char* a_base(const Unit& u) const { return (const char*)A + (size_t)u.pm * BM * K * 2; }
    __device__ __forceinline__ const char* b_base(const Unit& u) const { return (const char*)Bt + (size_t)u.pn * BM * K * 2; }
    __device__ __forceinline__ void a_offs(const Unit&, const int (&R)[2], const int (&C)[2], unsigned (&o)[2][2]) const {
#pragma unroll
        for (int h = 0; h < 2; ++h)
#pragma unroll
            for (int i = 0; i < 2; ++i) o[h][i] = (unsigned)((h * HALF + R[i]) * K + C[i]) * 2u;
    }
};

template <class Epi, class Sched>
__device__ __forceinline__ void gemm_phase(LAS unsigned char* lds, const int K, const Sched& S, const Epi& E) {
    const int tid = threadIdx.x, wid = __builtin_amdgcn_readfirstlane(tid >> 6), lane = tid & 63, wr = wid >> 2, wc = wid & 3, fr = lane & 15, fq = lane >> 4;
    const int nt = K / BK;
    int sR[2], sC[2]; unsigned voffB[2];
#pragma unroll
    for (int i = 0; i < 2; ++i) { stage_rc(tid * 16 + i * 8192, sR[i], sC[i]); const int Rb = Epi::PERM ? ((sR[i] & ~31) + perm32(sR[i] & 31)) : sR[i]; voffB[i] = (unsigned)(Rb * S.ldb + sC[i]) * 2u; }
    const size_t kstep = (size_t)(BK * 2);
    const size_t hstep = (size_t)HALF * S.ldb * 2;
    const unsigned ldsw = (unsigned)wid * 1024u;
    const int aoff = lds_byte(wr * 64 + fr, fq * 8), boff = lds_byte(wc * 32 + fr, fq * 8);
#define PG8_SA(b, h) (((b) * 2 + (h)) * HTB)
#define PG8_SB(b, h) ((4 + (b) * 2 + (h)) * HTB)
#define PG8_GLDS(src, dstoff) __builtin_amdgcn_global_load_lds((const unsigned*)(src), (LAS unsigned*)(lds + (dstoff)), 16, 0, 0)
#define PG8_STAGE_B(bufoff, gbase) do { PG8_GLDS((const char*)(gbase) + voffB[0], (bufoff) + ldsw); PG8_GLDS((const char*)(gbase) + voffB[1], (bufoff) + ldsw + 8192); } while (0)
#define PG8_STAGE_A(bufoff, gbase, o0, o1) do { PG8_GLDS((const char*)(gbase) + (o0), (bufoff) + ldsw); PG8_GLDS((const char*)(gbase) + (o1), (bufoff) + ldsw + 8192); } while (0)
#define PG8_LDA(dst, b, h) do { _Pragma("unroll") for (int m = 0; m < 4; ++m) _Pragma("unroll") for (int k = 0; k < 2; ++k) dst[m][k] = *(const LAS bf16x8*)(lds + PG8_SA(b, h) + aoff + m * 2048 + k * 1024); } while (0)
#define PG8_LDB(dst, b, h) do { _Pragma("unroll") for (int n = 0; n < 2; ++n) _Pragma("unroll") for (int k = 0; k < 2; ++k) dst[n][k] = *(const LAS bf16x8*)(lds + PG8_SB(b, h) + boff + n * 2048 + k * 1024); } while (0)
#define PG8_MMA(ai, bj, At, Bt) do { __builtin_amdgcn_s_setprio(1); _Pragma("unroll") for (int m = 0; m < 4; ++m) _Pragma("unroll") for (int n = 0; n < 2; ++n) _Pragma("unroll") for (int k = 0; k < 2; ++k) \
        acc[ai][bj][m][n] = __builtin_amdgcn_mfma_f32_16x16x32_bf16(Bt[n][k], At[m][k], acc[ai][bj][m][n], 0, 0, 0); __builtin_amdgcn_s_setprio(0); } while (0)
#define PG8_WAIT_V(n) asm volatile("s_waitcnt vmcnt(" #n ")" ::: "memory")
#define PG8_WAIT_L(n) asm volatile("s_waitcnt lgkmcnt(" #n ")" ::: "memory")
#define PG8_BAR __builtin_amdgcn_s_barrier()
#define PG8_SCHED __builtin_amdgcn_sched_barrier(0)
    Unit cur, nxt; int ui = 0;
    if (!S.next(0, cur)) return;
    f32x4 acc[2][2][4][2];
#pragma unroll
    for (int a = 0; a < 2; ++a)
#pragma unroll
        for (int b = 0; b < 2; ++b)
#pragma unroll
            for (int m = 0; m < 4; ++m)
#pragma unroll
                for (int n = 0; n < 2; ++n) acc[a][b][m][n] = (f32x4){0.f, 0.f, 0.f, 0.f};
    bf16x8 At[4][2], B0[2][2], B1[2][2];
    unsigned vc[2][2], vn[2][2];
    S.a_offs(cur, sR, sC, vc);
#pragma unroll
    for (int h = 0; h < 2; ++h) { vn[h][0] = vc[h][0]; vn[h][1] = vc[h][1]; }
    const char* cA = S.a_base(cur); const char* cB = S.b_base(cur);
    PG8_STAGE_B(PG8_SB(0, 0), cB); PG8_STAGE_B(PG8_SB(0, 1), cB + hstep); PG8_STAGE_A(PG8_SA(0, 0), cA, vc[0][0], vc[0][1]); PG8_STAGE_A(PG8_SA(0, 1), cA, vc[1][0], vc[1][1]);
    if (wr == 1) PG8_BAR;
    PG8_WAIT_V(2); PG8_BAR;
    PG8_STAGE_B(PG8_SB(1, 0), cB + kstep); PG8_STAGE_A(PG8_SA(1, 0), cA + kstep, vc[0][0], vc[0][1]); PG8_STAGE_B(PG8_SB(1, 1), cB + hstep + kstep);
    PG8_WAIT_V(6); PG8_BAR;
    for (;;) {
        const bool has_next = S.next(ui + 1, nxt);
        const char* nA = has_next ? S.a_base(nxt) : cA; const char* nB = has_next ? S.b_base(nxt) : cB;
        for (int t = 0; t < nt; t += 2) {
            const bool last = (t == nt - 2);
            if (last && has_next) S.a_offs(nxt, sR, sC, vn);
            const char* a1 = cA + (size_t)(t + 1) * kstep;
            const char* a2 = last ? nA : cA + (size_t)(t + 2) * kstep; const char* b2 = last ? nB : cB + (size_t)(t + 2) * kstep;
            const char* a3 = a2 + kstep; const char* b3 = b2 + kstep;
            const unsigned x00 = last ? vn[0][0] : vc[0][0], x01 = last ? vn[0][1] : vc[0][1], x10 = last ? vn[1][0] : vc[1][0], x11 = last ? vn[1][1] : vc[1][1];
            PG8_LDB(B0, 0, 0); PG8_LDB(B1, 0, 1); PG8_SCHED; PG8_LDA(At, 0, 0); PG8_STAGE_A(PG8_SA(1, 1), a1, vc[1][0], vc[1][1]);
            PG8_WAIT_V(8); PG8_WAIT_L(0); PG8_BAR; PG8_MMA(0, 0, At, B0); PG8_MMA(0, 1, At, B1); PG8_BAR; PG8_SCHED;
            PG8_LDA(At, 0, 1); PG8_STAGE_B(PG8_SB(0, 0), b2); PG8_STAGE_B(PG8_SB(0, 1), b2 + hstep); PG8_STAGE_A(PG8_SA(0, 0), a2, x00, x01);
            PG8_WAIT_V(8); PG8_WAIT_L(0); PG8_BAR; PG8_MMA(1, 0, At, B0); PG8_MMA(1, 1, At, B1); PG8_BAR; PG8_SCHED;
            PG8_LDB(B0, 1, 0); PG8_LDB(B1, 1, 1); PG8_SCHED; PG8_LDA(At, 1, 0); PG8_STAGE_A(PG8_SA(0, 1), a2, x10, x11);
            PG8_WAIT_V(8); PG8_WAIT_L(0); PG8_BAR; PG8_MMA(0, 0, At, B0); PG8_MMA(0, 1, At, B1); PG8_BAR; PG8_SCHED;
            PG8_LDA(At, 1, 1); PG8_STAGE_B(PG8_SB(1, 0), b3); PG8_STAGE_B(PG8_SB(1, 1), b3 + hstep); PG8_STAGE_A(PG8_SA(1, 0), a3, x00, x01);
            PG8_WAIT_V(8); PG8_WAIT_L(0); PG8_BAR; PG8_MMA(1, 0, At, B0); PG8_MMA(1, 1, At, B1); PG8_BAR; PG8_SCHED;
        }
        if (wr == 0) PG8_BAR;
        E(acc, cur, wr, wc, fr, fq);
        if (!has_next) break;
#pragma unroll
        for (int a = 0; a < 2; ++a)
#pragma unroll
            for (int b = 0; b < 2; ++b)
#pragma unroll
                for (int m = 0; m < 4; ++m)
#pragma unroll
                    for (int n = 0; n < 2; ++n) acc[a][b][m][n] = (f32x4){0.f, 0.f, 0.f, 0.f};
        cur = nxt; cA = nA; cB = nB; ++ui;
#pragma unroll
        for (int h = 0; h < 2; ++h) { vc[h][0] = vn[h][0]; vc[h][1] = vn[h][1]; }
        if (wr == 1) PG8_BAR;
    }
    PG8_WAIT_V(0);
    PG8_BAR;
#undef PG8_SA
#undef PG8_SB
#undef PG8_GLDS
#undef PG8_STAGE_A
#undef PG8_STAGE_B
#undef PG8_LDA
#undef PG8_LDB
#undef PG8_MMA
#undef PG8_WAIT_V
#undef PG8_WAIT_L
#undef PG8_BAR
#undef PG8_SCHED
}
}

struct Args { const float* in[18]; float* out; unsigned char* ws; int ph_lo, ph_hi; };

__device__ __forceinline__ void p0_adaln(const Args& a, LAS unsigned char* lds, float* mod) {
    const int tid = threadIdx.x;
    LAS float* sc = (LAS float*)lds;
    LAS float* red = (LAS float*)(lds + 16384);
    const float* c = a.in[1]; const float* ada_w = a.in[3]; const float* ada_b = a.in[4];
    for (int i = tid; i < 4096; i += NTHR) { const float v = c[i]; sc[i] = v / (1.f + expf(-v)); }
    __syncthreads();
    const int r = tid / 24, c4 = tid % 24;
    for (int cg = blockIdx.x; cg < 256; cg += gridDim.x) {
        const int idx = cg >> 6, col0 = (cg & 63) * 96;
        const float* W = ada_w + (size_t)idx * 2048 * 6144 + col0 + c4 * 4;
        f32x4 a0 = {0.f, 0.f, 0.f, 0.f}, a1 = {0.f, 0.f, 0.f, 0.f};
        if (tid < 504) {
            int k = r;
            for (; k + 63 < 2048; k += 84) {
                const f32x4 w0 = *(const f32x4*)(W + (size_t)k * 6144), w1 = *(const f32x4*)(W + (size_t)(k + 21) * 6144), w2 = *(const f32x4*)(W + (size_t)(k + 42) * 6144), w3 = *(const f32x4*)(W + (size_t)(k + 63) * 6144);
                a0 += sc[k] * w0; a1 += sc[2048 + k] * w0; a0 += sc[k + 21] * w1; a1 += sc[2048 + k + 21] * w1;
                a0 += sc[k + 42] * w2; a1 += sc[2048 + k + 42] * w2; a0 += sc[k + 63] * w3; a1 += sc[2048 + k + 63] * w3;
            }
            for (; k < 2048; k += 21) { const f32x4 w0 = *(const f32x4*)(W + (size_t)k * 6144); a0 += sc[k] * w0; a1 += sc[2048 + k] * w0; }
            *(LAS f32x4*)(red + (r * 24 + c4) * 8) = a0; *(LAS f32x4*)(red + (r * 24 + c4) * 8 + 4) = a1;
        }
        __syncthreads();
        if (tid < 192) {
            const int cc4 = tid >> 3, j = tid & 7; float s = 0.f;
            for (int rr = 0; rr < 21; ++rr) s += red[(rr * 24 + cc4) * 8 + j];
            const int b = j >> 2, col = col0 + cc4 * 4 + (j & 3);
            mod[(idx * 2 + b) * 6144 + col] = s + ada_b[idx * 6144 + col];
        }
        __syncthreads();
    }
}

struct TJob { const float* src; bf16_t* dst; int K, N, rowmode; };
__device__ __forceinline__ void p0_transpose_tile(const TJob& j, int tk, int tn, LAS unsigned* T2, int tid) {
    const int k0 = tk * 128, n0 = tn * 64;
    f32x4 f[2][2];
#pragma unroll
    for (int i = 0; i < 2; ++i) { const int p = i * 32 + (tid >> 4), c = (tid & 15) * 4;
        f[i][0] = *(const f32x4*)(j.src + (size_t)(k0 + 2 * p) * j.N + n0 + c); f[i][1] = *(const f32x4*)(j.src + (size_t)(k0 + 2 * p + 1) * j.N + n0 + c); }
    __syncthreads();
#pragma unroll
    for (int i = 0; i < 2; ++i) { const int p = i * 32 + (tid >> 4), c = (tid & 15) * 4;
#pragma unroll
        for (int e = 0; e < 4; ++e) T2[p * 65 + c + e] = pack_bf16(f[i][0][e], f[i][1][e]); }
    __syncthreads();
    const int n = tid >> 3, x = tid & 7;
    unsigned d[8];
#pragma unroll
    for (int jj = 0; jj < 8; ++jj) d[jj] = T2[(8 * x + jj) * 65 + n];
    const int nn = n0 + n;
    const int row = j.rowmode == 0 ? nn : ((nn >> 4) * 32 + (nn & 15) + (j.rowmode == 2 ? 16 : 0));
    bf16_t* dp = j.dst + (size_t)row * j.K + k0 + 16 * x;
    *(u32x4*)dp = (u32x4){d[0], d[1], d[2], d[3]}; *(u32x4*)(dp + 8) = (u32x4){d[4], d[5], d[6], d[7]};
}
__device__ __forceinline__ void p0_transposes(const Args& a, LAS unsigned char* lds) {
    const int tid = threadIdx.x; LAS unsigned* T2 = (LAS unsigned*)lds;
    unsigned char* ws = a.ws;
    for (int t = blockIdx.x; t < 30720; t += gridDim.x) {
        TJob j; int tk, tn;
        if (t < 4608) { j = TJob{a.in[5], (bf16_t*)(ws + WS_WQKV), 2048, 18432, 0}; tk = t / 288; tn = t % 288; }
        else if (t < 6144) { const int q = t - 4608, w = q / 512, r = q % 512; j = TJob{a.in[6 + w], (bf16_t*)(ws + (w == 0 ? WS_WO : (w == 1 ? WS_WIN : WS_WOUT))), 2048, 2048, 0}; tk = r / 32; tn = r % 32; }
        else if (t < 22528) { const int q = t - 6144, up = q / 8192, r = q % 8192, mat = r / 128, rr = r % 128;
            j = TJob{a.in[15 + up] + (size_t)mat * 2048 * 512, (bf16_t*)(ws + WS_WGU) + (size_t)mat * 1024 * 2048, 2048, 512, 1 + up}; tk = rr / 8; tn = rr % 8; }
        else { const int r = t - 22528, mat = r / 128, rr = r % 128; j = TJob{a.in[17] + (size_t)mat * 512 * 2048, (bf16_t*)(ws + WS_WD) + (size_t)mat * 2048 * 512, 512, 2048, 0}; tk = rr / 32; tn = rr % 32; }
        p0_transpose_tile(j, tk, tn, T2, tid);
    }
    __syncthreads();
}
__device__ __forceinline__ void p0_tables(const Args& a, float* rot) {
    const int* pos = (const int*)a.in[2];
    for (int i = blockIdx.x * NTHR + threadIdx.x; i < T * 16; i += gridDim.x * NTHR) {
        const int t = i >> 4, j = i & 15;
        const float invf = (float)pow(500000.0, -(double)j / 16.0);
        const float ang = (float)pos[t] * invf;
        double r = (double)ang * 0.31830988618379067154; r -= 2.0 * rint(r * 0.5);
        float s, c; sincospif((float)r, &s, &c);
        rot[t * 32 + j] = c; rot[t * 32 + 16 + j] = s;
    }
}
__device__ __forceinline__ void p_modulate(const float* __restrict__ x, const float* __restrict__ mod, bf16_t* __restrict__ h) {
    for (size_t i = (size_t)blockIdx.x * NTHR + threadIdx.x; i < (size_t)T * D / 8; i += (size_t)gridDim.x * NTHR) {
        const size_t e = i * 8; const int t = (int)(e >> 11), d = (int)(e & 2047), b = t >> 12;
        const f32x4 x0 = *(const f32x4*)(x + e), x1 = *(const f32x4*)(x + e + 4);
        const float* m = mod + b * 6144 + d;
        const f32x4 sh0 = *(const f32x4*)m, sh1 = *(const f32x4*)(m + 4), sc0 = *(const f32x4*)(m + 2048), sc1 = *(const f32x4*)(m + 2052);
        const f32x4 y0 = x0 * (1.f + sc0) + sh0, y1 = x1 * (1.f + sc1) + sh1;
        *(u32x4*)(h + e) = (u32x4){pack_bf16(y0[0], y0[1]), pack_bf16(y0[2], y0[3]), pack_bf16(y1[0], y1[1]), pack_bf16(y1[2], y1[3])};
    }
}
struct EpiQKV {
    static constexpr bool PERM = true;
    bf16_t* Qf; bf16_t* Kf; bf16_t* Vf; const float* rot;
    __device__ __forceinline__ void operator()(const f32x4 (&acc)[2][2][4][2], const pg8::Unit& u, int wr, int wc, int fr, int fq) const {
        const int n0 = u.pn * 256, g = n0 / 6144, which = (n0 % 6144) >> 11, head0 = (n0 & 2047) >> 7;
        const int sh = g * 2, nbr = 128 >> sh;
#pragma unroll
        for (int ai = 0; ai < 2; ++ai)
#pragma unroll
            for (int m = 0; m < 4; ++m) {
                const int row = u.pm * 256 + ai * 128 + wr * 64 + m * 16 + fr, b = row >> 12, s = row & 4095;
                const int r = s & ((1 << sh) - 1), j = s >> sh, jo = j & 31, blk = r * nbr + (j >> 5);
                f32x4 cs0 = {1.f, 1.f, 1.f, 1.f}, cs1 = cs0, sn0 = {0.f, 0.f, 0.f, 0.f}, sn1 = sn0;
                const bool dorot = (which < 2) && (wc == 0);
                if (dorot) { const float* rp = rot + (size_t)row * 32 + 8 * (fq & 1); cs0 = *(const f32x4*)rp; cs1 = *(const f32x4*)(rp + 4); sn0 = *(const f32x4*)(rp + 16); sn1 = *(const f32x4*)(rp + 20); }
#pragma unroll
                for (int bj = 0; bj < 2; ++bj) {
                    const size_t blkid = (size_t)(((g * 2 + b) * 16 + head0 + bj) * 128 + blk);
                    float v[8];
#pragma unroll
                    for (int e = 0; e < 4; ++e) { v[e] = acc[ai][bj][m][0][e]; v[4 + e] = acc[ai][bj][m][1][e]; }
                    if (which < 2) {
                        if (wc == 0) {
#pragma unroll
                            for (int e = 0; e < 8; ++e) { const float p = __shfl_xor(v[e], 32); const float cc = e < 4 ? cs0[e] : cs1[e - 4], ss = e < 4 ? sn0[e] : sn1[e - 4];
                                v[e] = fq < 2 ? v[e] * cc - p * ss : v[e] * cc + p * ss; }
                        }
                        if (which == 0) {
#pragma unroll
                            for (int e = 0; e < 8; ++e) v[e] *= QSCALE;
                        }
                        const int c = 4 * wc + fq, ks = c >> 1, hh = c & 1;
                        const size_t slot = (blkid * 8 + ks) * 64 + hh * 32 + (which == 0 ? jo : pi32(jo));
                        *(u32x4*)((which == 0 ? Qf : Kf) + slot * 8) = (u32x4){pack_bf16(v[0], v[1]), pack_bf16(v[2], v[3]), pack_bf16(v[4], v[5]), pack_bf16(v[6], v[7])};
                    } else {
                        const size_t slot0 = (blkid * 8 + wc * 2 + (jo >> 4)) * 64 + ((jo >> 3) & 1) * 32 + 8 * fq;
                        bf16_t* vp = Vf + slot0 * 8 + (jo & 7);
#pragma unroll
                        for (int e = 0; e < 8; e += 2) { const unsigned w = pack_bf16(v[e], v[e + 1]); vp[e * 8] = (bf16_t)(w & 0xffffu); vp[(e + 1) * 8] = (bf16_t)(w >> 16); }
                    }
                }
            }
    }
};

__device__ __forceinline__ void p_attention(const bf16_t* __restrict__ Qf, const bf16_t* __restrict__ Kf, const bf16_t* __restrict__ Vf, bf16_t* __restrict__ og, float* __restrict__ lse) {
    const int lane = threadIdx.x & 63, wave = __builtin_amdgcn_readfirstlane(threadIdx.x >> 6);
    const int qo = lane & 31, hh = lane >> 5;
    const int nwaves = gridDim.x * 8, wg = blockIdx.x * 8 + wave;
    for (int item = wg; item < 3 * 4096; item += nwaves) {
        const int g = item >> 12, rem = item & 4095, b = rem >> 11, head = (rem >> 7) & 15, blk = rem & 127;
        const int sh = g * 2, nbr = 128 >> sh, r = blk / nbr, jb = blk % nbr;
        const size_t base = (size_t)(((g * 2 + b) * 16 + head) * 128);
        bf16x8 qf[8];
#pragma unroll
        for (int ks = 0; ks < 8; ++ks) qf[ks] = *(const bf16x8*)(Qf + (((base + blk) * 8 + ks) * 64 + lane) * 8);
        f32x16 O[4];
#pragma unroll
        for (int db = 0; db < 4; ++db)
#pragma unroll
            for (int e = 0; e < 16; ++e) O[db][e] = 0.f;
        float m = -1e30f, l = 0.f;
        for (int kb = jb - 2; kb <= jb + 2; ++kb) {
            if (kb < 0 || kb >= nbr) continue;
            const size_t kblk = base + r * nbr + kb;
            bf16x8 kf[8], vf[8];
#pragma unroll
            for (int ks = 0; ks < 8; ++ks) kf[ks] = *(const bf16x8*)(Kf + ((kblk * 8 + ks) * 64 + lane) * 8);
#pragma unroll
            for (int ks = 0; ks < 8; ++ks) vf[ks] = *(const bf16x8*)(Vf + ((kblk * 8 + ks) * 64 + lane) * 8);
            f32x16 S;
#pragma unroll
            for (int e = 0; e < 16; ++e) S[e] = 0.f;
#pragma unroll
            for (int ks = 0; ks < 8; ++ks) S = __builtin_amdgcn_mfma_f32_32x32x16_bf16(kf[ks], qf[ks], S, 0, 0, 0);
            if (kb == jb - 2) {
#pragma unroll
                for (int e = 0; e < 16; ++e) { const int ko = 16 * (e >> 3) + 8 * hh + (e & 7); if (ko < qo) S[e] = -1e30f; }
            }
            if (kb == jb + 2) {
#pragma unroll
                for (int e = 0; e < 16; ++e) { const int ko = 16 * (e >> 3) + 8 * hh + (e & 7); if (ko > qo) S[e] = -1e30f; }
            }
            float bm = S[0];
#pragma unroll
            for (int e = 1; e < 16; ++e) bm = fmaxf(bm, S[e]);
            bm = fmaxf(bm, __shfl_xor(bm, 32));
            const float mn = fmaxf(m, bm), alpha = exp2f(m - mn);
            float ls = 0.f;
#pragma unroll
            for (int e = 0; e < 16; ++e) { S[e] = exp2f(S[e] - mn); ls += S[e]; }
            l = l * alpha + ls; m = mn;
#pragma unroll
            for (int db = 0; db < 4; ++db)
#pragma unroll
                for (int e = 0; e < 16; ++e) O[db][e] *= alpha;
            bf16x8 pf[2];
#pragma unroll
            for (int s2 = 0; s2 < 2; ++s2) { u32x4 w = {pack_bf16(S[8 * s2], S[8 * s2 + 1]), pack_bf16(S[8 * s2 + 2], S[8 * s2 + 3]), pack_bf16(S[8 * s2 + 4], S[8 * s2 + 5]), pack_bf16(S[8 * s2 + 6], S[8 * s2 + 7])};
                pf[s2] = __builtin_bit_cast(bf16x8, w); }
#pragma unroll
            for (int db = 0; db < 4; ++db)
#pragma unroll
                for (int s2 = 0; s2 < 2; ++s2) O[db] = __builtin_amdgcn_mfma_f32_32x32x16_bf16(vf[db * 2 + s2], pf[s2], O[db], 0, 0, 0);
        }
        const float lt = l + __shfl_xor(l, 32), inv = 1.f / lt;
        const int s = r + ((32 * jb + qo) << sh), t = b * SEQ + s;
        bf16_t* op = og + ((size_t)g * T + t) * D + head * 128 + 4 * hh;
#pragma unroll
        for (int db = 0; db < 4; ++db)
#pragma unroll
            for (int q4 = 0; q4 < 4; ++q4) {
                const u32x2 w = {pack_bf16(O[db][4 * q4] * inv, O[db][4 * q4 + 1] * inv), pack_bf16(O[db][4 * q4 + 2] * inv, O[db][4 * q4 + 3] * inv)};
                *(u32x2*)(op + 32 * db + 8 * q4) = w;
            }
        if (hh == 0) lse[((size_t)g * T + t) * 16 + head] = m + log2f(lt);
    }
}
__device__ __forceinline__ void p_combine(const bf16_t* __restrict__ og, const float* __restrict__ lse, bf16_t* __restrict__ o) {
    for (size_t i = (size_t)blockIdx.x * NTHR + threadIdx.x; i < (size_t)T * D / 8; i += (size_t)gridDim.x * NTHR) {
        const size_t e = i * 8; const int t = (int)(e >> 11), head = (int)((e & 2047) >> 7);
        const float l0 = lse[((size_t)0 * T + t) * 16 + head], l1 = lse[((size_t)1 * T + t) * 16 + head], l2 = lse[((size_t)2 * T + t) * 16 + head];
        const float mx = fmaxf(l0, fmaxf(l1, l2));
        float w0 = exp2f(l0 - mx), w1 = exp2f(l1 - mx), w2 = exp2f(l2 - mx); const float inv = 1.f / (w0 + w1 + w2); w0 *= inv; w1 *= inv; w2 *= inv;
        const u32x4 a0 = *(const u32x4*)(og + e), a1 = *(const u32x4*)(og + (size_t)T * D + e), a2 = *(const u32x4*)(og + (size_t)2 * T * D + e);
        u32x4 res;
#pragma unroll
        for (int k = 0; k < 4; ++k) {
            const float lo = w0 * __uint_as_float(a0[k] << 16) + w1 * __uint_as_float(a1[k] << 16) + w2 * __uint_as_float(a2[k] << 16);
            const float hi = w0 * __uint_as_float(a0[k] & 0xffff0000u) + w1 * __uint_as_float(a1[k] & 0xffff0000u) + w2 * __uint_as_float(a2[k] & 0xffff0000u);
            res[k] = pack_bf16(lo, hi);
        }
        *(u32x4*)(o + e) = res;
    }
}


constexpr size_t WS_Y = WS_QF;
constexpr size_t WS_ACT = WS_Y + 32 * MB;
constexpr size_t WS_YB = WS_ACT + 24 * MB;
constexpr size_t WS_U = WS_YB + 64 * MB;
constexpr size_t WS_ABT = WS_U + 32 * MB;
constexpr size_t WS_YF = WS_ABT + 64 * MB;
constexpr size_t WS_X1 = WS_FAST_END;
constexpr size_t WS_X2 = WS_X1 + 64 * MB;
constexpr size_t WS_DM = WS_X2 + 64 * MB;
constexpr size_t WS_END2 = WS_DM + 64 * MB;
static_assert(WS_YF + 32 * MB <= WS_FAST_END, "overlay");
constexpr int LDS_TB = LDS_MISC + 64;

struct EpiBf16 {
    static constexpr bool PERM = true;
    bf16_t* O; int ldc; float scale; int mode;
    __device__ __forceinline__ void operator()(const f32x4 (&acc)[2][2][4][2], const pg8::Unit& u, int wr, int wc, int fr, int fq) const {
        bf16_t* base = O + (mode == 1 ? (size_t)u.e * 1024 * 4096 : (size_t)0);
        const int row0 = u.pm * 256 + wr * 64 + fr, col0 = u.pn * 256 + wc * 32 + 8 * fq;
#pragma unroll
        for (int ai = 0; ai < 2; ++ai)
#pragma unroll
            for (int m = 0; m < 4; ++m) { bf16_t* rowp = base + (size_t)(row0 + ai * 128 + m * 16) * ldc + col0;
#pragma unroll
                for (int bj = 0; bj < 2; ++bj) { const f32x4 v0 = acc[ai][bj][m][0] * scale, v1 = acc[ai][bj][m][1] * scale;
                    *(u32x4*)(rowp + bj * 128) = (u32x4){pack_bf16(v0[0], v0[1]), pack_bf16(v0[2], v0[3]), pack_bf16(v1[0], v1[1]), pack_bf16(v1[2], v1[3])}; } }
    }
};

template <int NY, bool LAST>
__device__ __forceinline__ void row_ln(const int row, const int lane, const float* __restrict__ xin, const bf16_t* __restrict__ y0, const bf16_t* __restrict__ y1, const float* __restrict__ modg,
                                       const float* __restrict__ lnw, const float* __restrict__ lnb, float* __restrict__ xout, const float* __restrict__ modn, bf16_t* __restrict__ hout, f32x4 (&h)[8]) {
    const int b = row >> 12; unsigned lo4 = 4u * (unsigned)lane;
    asm volatile("" : "+v"(lo4));
    const float* xr = xin + (size_t)row * D; const bf16_t* y0r = y0 + (size_t)row * D; const bf16_t* y1r = y1 + (size_t)row * D; const float* gr = modg + b * 6144 + 4096;
    f32x4 z[8]; float sum = 0.f;
#pragma unroll
    for (int i = 0; i < 8; ++i) {
        const f32x4 xv = *(const f32x4*)(xr + 256 * i + lo4); const f32x4 gt = *(const f32x4*)(gr + 256 * i + lo4);
        const u32x2 ya = *(const u32x2*)(y0r + 256 * i + lo4);
        f32x4 yv = {__uint_as_float(ya[0] << 16), __uint_as_float(ya[0] & 0xffff0000u), __uint_as_float(ya[1] << 16), __uint_as_float(ya[1] & 0xffff0000u)};
        if (NY == 2) { const u32x2 yb = *(const u32x2*)(y1r + 256 * i + lo4); yv += (f32x4){__uint_as_float(yb[0] << 16), __uint_as_float(yb[0] & 0xffff0000u), __uint_as_float(yb[1] << 16), __uint_as_float(yb[1] & 0xffff0000u)}; }
        z[i] = ALPHA * xv + gt * yv; sum += (z[i][0] + z[i][1]) + (z[i][2] + z[i][3]); }
#pragma unroll
    for (int o2 = 32; o2 >= 1; o2 >>= 1) sum += __shfl_xor(sum, o2);
    const float mean = sum * (1.f / D); float q = 0.f;
#pragma unroll
    for (int i = 0; i < 8; ++i) { const f32x4 dd = z[i] - mean; q += (dd[0] * dd[0] + dd[1] * dd[1]) + (dd[2] * dd[2] + dd[3] * dd[3]); }
#pragma unroll
    for (int o2 = 32; o2 >= 1; o2 >>= 1) q += __shfl_xor(q, o2);
    const float rstd = 1.0f / sqrtf(q * (1.f / D) + LN_EPS);
    float* xo_r = xout + (size_t)row * D; bf16_t* ho_r = hout + (size_t)row * D; const float* shr = modn + b * 6144; const float* scr = modn + b * 6144 + 2048;
#pragma unroll
    for (int i = 0; i < 8; ++i) {
        const f32x4 xo = (z[i] - mean) * rstd * *(const f32x4*)(lnw + 256 * i + lo4) + *(const f32x4*)(lnb + 256 * i + lo4);
        *(f32x4*)(xo_r + 256 * i + lo4) = xo;
        if (!LAST) { const f32x4 hv = xo * (1.f + *(const f32x4*)(scr + 256 * i + lo4)) + *(const f32x4*)(shr + 256 * i + lo4);
            *(u32x2*)(ho_r + 256 * i + lo4) = (u32x2){pack_bf16(hv[0], hv[1]), pack_bf16(hv[2], hv[3])}; h[i] = hv; }
        if ((i & 3) == 3) __builtin_amdgcn_sched_barrier(0); }
}
#define LDS6(w, addr, o0) asm volatile("ds_read_b128 %0, %6 offset:%7\n\tds_read_b128 %1, %6 offset:%8\n\tds_read_b128 %2, %6 offset:%9\n\tds_read_b128 %3, %6 offset:%10\n\tds_read_b128 %4, %6 offset:%11\n\tds_read_b128 %5, %6 offset:%12\n\ts_waitcnt lgkmcnt(0)" \
    : "=&v"(w[0]), "=&v"(w[1]), "=&v"(w[2]), "=&v"(w[3]), "=&v"(w[4]), "=&v"(w[5]) : "v"(addr), "i"(o0), "i"((o0) + 2048), "i"((o0) + 4096), "i"((o0) + 6144), "i"((o0) + 8192), "i"((o0) + 10240) : "memory")
template <int Q>
__device__ __forceinline__ void router_round(LAS float* wT, const int tid, const int lane, const float* __restrict__ wr1, const float* __restrict__ wr2, const f32x4 (&h0)[8], const f32x4 (&h1)[8], float (&acc0)[36], float (&acc1)[36]) {
    __syncthreads();
#pragma unroll 1
    for (int id = tid; id < 512 * 9; id += NTHR) { const int kl = id / 9, f = id % 9, k = Q * 512 + kl;
        const f32x4 w = f == 0 ? *(const f32x4*)(wr1 + k * 4) : *(const f32x4*)(wr2 + k * 32 + (f - 1) * 4); const int c0 = f == 0 ? 0 : 4 * f;
        wT[(c0 + 0) * 512 + kl] = w[0]; wT[(c0 + 1) * 512 + kl] = w[1]; wT[(c0 + 2) * 512 + kl] = w[2]; wT[(c0 + 3) * 512 + kl] = w[3]; }
    __syncthreads();
    unsigned a0 = (unsigned)(size_t)wT + 16u * (unsigned)lane; asm volatile("" : "+v"(a0)); const unsigned a1 = a0 + 24u * 2048u;
#define RR_GROUP(ha, hb, base, c6, off) do { f32x4 w[6]; LDS6(w, base, off); _Pragma("unroll") for (int c = 0; c < 6; ++c) { \
        acc0[(c6) + c] += (ha[0] * w[c][0] + ha[1] * w[c][1]) + (ha[2] * w[c][2] + ha[3] * w[c][3]); acc1[(c6) + c] += (hb[0] * w[c][0] + hb[1] * w[c][1]) + (hb[2] * w[c][2] + hb[3] * w[c][3]); } \
        asm volatile("" : "+v"(acc0[(c6)]), "+v"(acc0[(c6) + 1]), "+v"(acc0[(c6) + 2]), "+v"(acc0[(c6) + 3]), "+v"(acc0[(c6) + 4]), "+v"(acc0[(c6) + 5]), \
                          "+v"(acc1[(c6)]), "+v"(acc1[(c6) + 1]), "+v"(acc1[(c6) + 2]), "+v"(acc1[(c6) + 3]), "+v"(acc1[(c6) + 4]), "+v"(acc1[(c6) + 5])); } while (0)
    { const f32x4 ha = h0[2 * Q], hb = h1[2 * Q];
      RR_GROUP(ha, hb, a0, 0, 0); RR_GROUP(ha, hb, a0, 6, 12288); RR_GROUP(ha, hb, a0, 12, 24576); RR_GROUP(ha, hb, a0, 18, 36864); RR_GROUP(ha, hb, a1, 24, 0); RR_GROUP(ha, hb, a1, 30, 12288); }
    { const f32x4 ha = h0[2 * Q + 1], hb = h1[2 * Q + 1];
      RR_GROUP(ha, hb, a0, 0, 1024); RR_GROUP(ha, hb, a0, 6, 13312); RR_GROUP(ha, hb, a0, 12, 25600); RR_GROUP(ha, hb, a0, 18, 37888); RR_GROUP(ha, hb, a1, 24, 1024); RR_GROUP(ha, hb, a1, 30, 13312); }
#undef RR_GROUP
}
template <int NLO, int NHI, int BIT>
__device__ __forceinline__ void rs_level(const float (&r)[NLO + NHI], float (&o)[NLO], const int lane) {
    const bool hi = (lane >> BIT) & 1;
#pragma unroll
    for (int c = 0; c < NLO; ++c) { const float lov = r[c], hiv = c < NHI ? r[c + NLO] : 0.f; const float send = hi ? lov : hiv; o[c] = (hi ? hiv : lov) + __shfl_xor(send, 1 << BIT); }
}
__device__ __forceinline__ void route_row(const float (&acc)[36], const int lrow, const int row, const int lane, LAS float* lg, const float* __restrict__ br1, const float* __restrict__ br2, float* __restrict__ gw, LAS int* hist, LAS int* asgE, LAS int* asgP) {
    float r18[18], r9[9], r5[5], r3[3], r2[2], r1[1];
    rs_level<18, 18, 5>(acc, r18, lane); rs_level<9, 9, 4>(r18, r9, lane); rs_level<5, 4, 3>(r9, r5, lane); rs_level<3, 2, 2>(r5, r3, lane); rs_level<2, 1, 1>(r3, r2, lane); rs_level<1, 1, 0>(r2, r1, lane);
    const int idx3 = ((lane >> 1) & 1) * 2 + (lane & 1), idx5 = ((lane >> 2) & 1) * 3 + idx3;
    const bool valid = (idx3 <= 2) && (idx5 <= (((lane >> 3) & 1) ? 3 : 4));
    const int col = ((lane >> 5) & 1) * 18 + ((lane >> 4) & 1) * 9 + ((lane >> 3) & 1) * 5 + idx5;
    if (valid) lg[col] = r1[0];
    asm volatile("s_waitcnt lgkmcnt(0)" ::: "memory");
    float lc[4]; float mx = -1e30f; int gi = 0;
#pragma unroll
    for (int j = 0; j < 4; ++j) { lc[j] = lg[j] + br1[j]; const bool gt = lc[j] > mx; mx = gt ? lc[j] : mx; gi = gt ? j : gi; }
    float den = 0.f;
#pragma unroll
    for (int j = 0; j < 4; ++j) den += expf(lc[j] - mx);
    const float pg = 1.f / den;
    float v1 = -1e30f, v2 = -1e30f; int i1 = 0, i2 = 0;
#pragma unroll
    for (int j = 0; j < 8; ++j) { const float v = lg[4 + gi * 8 + j] + br2[gi * 8 + j];
        const bool b1 = v > v1, b2 = v > v2;
        v2 = b1 ? v1 : (b2 ? v : v2); i2 = b1 ? i1 : (b2 ? j : i2); v1 = b1 ? v : v1; i1 = b1 ? j : i1; }
    const float e2 = expf(v2 - v1), g1 = pg / (1.f + e2), g2 = pg * e2 / (1.f + e2);
    if (lane == 0) { const int ea = gi * 8 + i1, eb = gi * 8 + i2;
        gw[row * 2] = g1; gw[row * 2 + 1] = g2;
        asgE[lrow * 2] = ea; asgP[lrow * 2] = __hip_atomic_fetch_add(&hist[ea], 1, __ATOMIC_RELAXED, __HIP_MEMORY_SCOPE_WORKGROUP);
        asgE[lrow * 2 + 1] = eb; asgP[lrow * 2 + 1] = __hip_atomic_fetch_add(&hist[eb], 1, __ATOMIC_RELAXED, __HIP_MEMORY_SCOPE_WORKGROUP); }
}
template <int NY, bool ROUTER, bool LAST>
__device__ __forceinline__ void p_rows(LAS unsigned char* lds, const float* __restrict__ xin, const bf16_t* __restrict__ y0, const bf16_t* __restrict__ y1, const float* __restrict__ modg,
                                       const float* __restrict__ lnw, const float* __restrict__ lnb, float* __restrict__ xout, const float* __restrict__ modn, bf16_t* __restrict__ hout,
                                       const float* __restrict__ wr1, const float* __restrict__ br1, const float* __restrict__ wr2, const float* __restrict__ br2,
                                       float* __restrict__ gw, int* __restrict__ list, unsigned* __restrict__ cnt) {
    const int tid = threadIdx.x, lane = tid & 63, wave = __builtin_amdgcn_readfirstlane(tid >> 6);
    LAS float* wT = (LAS float*)lds;
    LAS int* hist = (LAS int*)(lds + 73728);
    LAS float* lgs = (LAS float*)(lds + 73728 + 1024);
    LAS int* basee = hist + 32;
    LAS int* asgE = hist + 64;
    LAS int* asgP = hist + 128;
    for (int rb = blockIdx.x; rb < 256; rb += gridDim.x) {
        if (ROUTER) { if (tid < 32) hist[tid] = 0; __syncthreads(); }
#pragma unroll 1
        for (int p = 0; p < 2; ++p) {
            const int lrow = wave * 4 + p * 2, row = rb * 32 + lrow;
            f32x4 h0[8], h1[8];
            row_ln<NY, LAST>(row, lane, xin, y0, y1, modg, lnw, lnb, xout, modn, hout, h0);
            row_ln<NY, LAST>(row + 1, lane, xin, y0, y1, modg, lnw, lnb, xout, modn, hout, h1);
            if (ROUTER) {
                float acc0[36], acc1[36];
#pragma unroll
                for (int c = 0; c < 36; ++c) { acc0[c] = 0.f; acc1[c] = 0.f; }
                router_round<0>(wT, tid, lane, wr1, wr2, h0, h1, acc0, acc1);
                router_round<1>(wT, tid, lane, wr1, wr2, h0, h1, acc0, acc1);
                router_round<2>(wT, tid, lane, wr1, wr2, h0, h1, acc0, acc1);
                router_round<3>(wT, tid, lane, wr1, wr2, h0, h1, acc0, acc1);
                route_row(acc0, lrow, row, lane, lgs + lrow * 40, br1, br2, gw, hist, asgE, asgP);
                route_row(acc1, lrow + 1, row + 1, lane, lgs + (lrow + 1) * 40, br1, br2, gw, hist, asgE, asgP);
            }
        }
        if (ROUTER) {
            __syncthreads();
            if (tid < 32) { const int n = hist[tid]; basee[tid] = n ? (int)__hip_atomic_fetch_add(cnt + tid, (unsigned)n, __ATOMIC_RELAXED, __HIP_MEMORY_SCOPE_AGENT) : 0; }
            __syncthreads();
            if (tid < 64) { const int e = asgE[tid]; list[e * 8192 + basee[e] + asgP[tid]] = (rb * 32 + (tid >> 1)) * 2 + (tid & 1); }
            __syncthreads();
        }
    }
}

__device__ __forceinline__ void moe_setup(LAS unsigned char* lds, const unsigned* cnt) {
    LAS int* tb = (LAS int*)(lds + LDS_TB);
    if (threadIdx.x == 0) { int s = 0; for (int e = 0; e < 32; ++e) { const int c = (int)__hip_atomic_load(cnt + e, __ATOMIC_RELAXED, __HIP_MEMORY_SCOPE_AGENT); tb[e] = s; tb[33 + e] = c; s += (c + 255) >> 8; } tb[32] = s; }
    __syncthreads();
}
struct MoeSched {
    LAS const int* tb; const bf16_t* A; const bf16_t* Bt; const int* list; int K, ldb, NT, ntshift, nrowsB, G, c; bool gather;
    __device__ bool next(int i, pg8::Unit& u) const {
        const int L = i * G + c, tm = L >> ntshift; if (tm >= tb[32]) return false;
        int e = 0;
#pragma unroll 1
        for (int k = 1; k < 32; ++k) e = (tb[k] <= tm) ? k : e;
        u.pm = tm; u.pn = L & (NT - 1); u.e = e; u.row0 = (tm - tb[e]) << 8; return true;
    }
    __device__ __forceinline__ const char* a_base(const pg8::Unit& u) const { return gather ? (const char*)A : (const char*)A + (size_t)u.pm * 256 * K * 2; }
    __device__ __forceinline__ const char* b_base(const pg8::Unit& u) const { return (const char*)Bt + ((size_t)u.e * nrowsB + (size_t)u.pn * 256) * K * 2; }
    __device__ __forceinline__ void a_offs(const pg8::Unit& u, const int (&R)[2], const int (&C)[2], unsigned (&o)[2][2]) const {
        const int cn = tb[33 + u.e];
#pragma unroll
        for (int h = 0; h < 2; ++h)
#pragma unroll
            for (int i = 0; i < 2; ++i) {
                if (gather) { const int row = u.row0 + h * 128 + R[i]; const int tok = row < cn ? (list[u.e * 8192 + row] >> 1) : 0; o[h][i] = (unsigned)(tok * K + C[i]) * 2u; }
                else o[h][i] = (unsigned)((h * 128 + R[i]) * K + C[i]) * 2u;
            }
    }
};
struct EpiAct {
    static constexpr bool PERM = false;
    bf16_t* act;
    __device__ __forceinline__ void operator()(const f32x4 (&acc)[2][2][4][2], const pg8::Unit& u, int wr, int wc, int fr, int fq) const {
#pragma unroll
        for (int ai = 0; ai < 2; ++ai)
#pragma unroll
            for (int m = 0; m < 4; ++m) { const int arow = u.pm * 256 + ai * 128 + wr * 64 + m * 16 + fr;
#pragma unroll
                for (int bj = 0; bj < 2; ++bj) { const int j0 = (8 * u.pn + 4 * bj + wc) * 16 + 4 * fq; const f32x4 g = acc[ai][bj][m][0], up = acc[ai][bj][m][1]; f32x4 a;
#pragma unroll
                    for (int e = 0; e < 4; ++e) a[e] = g[e] / (1.f + __expf(-g[e])) * up[e];
                    *(u32x2*)(act + (size_t)arow * 512 + j0) = (u32x2){pack_bf16(a[0], a[1]), pack_bf16(a[2], a[3])}; } }
    }
};
struct EpiDown {
    static constexpr bool PERM = true;
    LAS const int* tb; const int* list; const float* gw; bf16_t* yb;
    __device__ __forceinline__ void operator()(const f32x4 (&acc)[2][2][4][2], const pg8::Unit& u, int wr, int wc, int fr, int fq) const {
        const int cn = tb[33 + u.e], col0 = u.pn * 256 + wc * 32 + 8 * fq;
#pragma unroll
        for (int ai = 0; ai < 2; ++ai)
#pragma unroll
            for (int m = 0; m < 4; ++m) { const int row = u.row0 + ai * 128 + wr * 64 + m * 16 + fr;
                if (row < cn) { const int a = list[u.e * 8192 + row]; const float w = gw[a]; bf16_t* rowp = yb + (size_t)(a & 1) * T * D + (size_t)(a >> 1) * D + col0;
#pragma unroll
                    for (int bj = 0; bj < 2; ++bj) { const f32x4 v0 = acc[ai][bj][m][0] * w, v1 = acc[ai][bj][m][1] * w;
                        *(u32x4*)(rowp + bj * 128) = (u32x4){pack_bf16(v0[0], v0[1]), pack_bf16(v0[2], v0[3]), pack_bf16(v1[0], v1[1]), pack_bf16(v1[2], v1[3])}; } } }
    }
};

__device__ __forceinline__ void p0_dft(LAS unsigned char* lds, bf16_t* Dc, bf16_t* Dm) {
    LAS float* tab = (LAS float*)lds;
    __syncthreads();
    for (int i = threadIdx.x; i < 4096; i += NTHR) { float s, c; sincospif((float)i / 2048.0f, &s, &c); tab[i] = c; }
    __syncthreads();
    for (size_t i = (size_t)blockIdx.x * NTHR + threadIdx.x; i < (size_t)4096 * 8192 / 8; i += (size_t)gridDim.x * NTHR) {
        const size_t e = i * 8; const int sp = (int)(e >> 13), k = (int)(e & 8191), part = k >> 12, s0 = k & 4095; unsigned w[4];
#pragma unroll
        for (int j = 0; j < 8; j += 2) { const int i0 = (sp * (s0 + j)) & 4095, i1 = (sp * (s0 + j + 1)) & 4095;
            const float a = part ? -tab[(i0 - 1024) & 4095] : tab[i0], b = part ? -tab[(i1 - 1024) & 4095] : tab[i1]; w[j >> 1] = pack_bf16(a, b); }
        *(u32x4*)(Dm + e) = (u32x4){w[0], w[1], w[2], w[3]};
    }
    for (size_t i = (size_t)blockIdx.x * NTHR + threadIdx.x; i < (size_t)1024 * 512 / 8; i += (size_t)gridDim.x * NTHR) {
        const size_t e = i * 8; const int m = (int)(e >> 9), c0 = (int)(e & 511), cp = m >> 1, part = m & 1; unsigned w[4];
#pragma unroll
        for (int j = 0; j < 8; j += 2) { const int i0 = (((c0 + j) * cp) & 511) * 8, i1 = (((c0 + j + 1) * cp) & 511) * 8;
            const float a = part ? tab[(i0 - 1024) & 4095] : tab[i0], b = part ? tab[(i1 - 1024) & 4095] : tab[i1]; w[j >> 1] = pack_bf16(a, b); }
        *(u32x4*)(Dc + e) = (u32x4){w[0], w[1], w[2], w[3]};
    }
    __syncthreads();
}
struct ChanSched {
    const bf16_t* Dc; const bf16_t* u; int K, ldb, G, c;
    __device__ bool next(int i, pg8::Unit& un) const { const int L = i * G + c; if (L >= 512) return false; un.e = L >> 6; const int rem = L & 63; un.pm = rem & 3; un.pn = rem >> 2; un.row0 = 0; return true; }
    __device__ __forceinline__ const char* a_base(const pg8::Unit& un) const { return (const char*)Dc + (size_t)un.pm * 256 * 512 * 2; }
    __device__ __forceinline__ const char* b_base(const pg8::Unit& un) const { return (const char*)u + ((size_t)((un.e >> 2) * 4096 + un.pn * 256) * 2048 + (un.e & 3) * 512) * 2; }
    __device__ __forceinline__ void a_offs(const pg8::Unit&, const int (&R)[2], const int (&C)[2], unsigned (&o)[2][2]) const {
#pragma unroll
        for (int h = 0; h < 2; ++h)
#pragma unroll
            for (int i = 0; i < 2; ++i) o[h][i] = (unsigned)((h * 128 + R[i]) * 512 + C[i]) * 2u; }
};
struct SeqSched {
    const bf16_t* Dm; const bf16_t* ABt; int K, ldb, G, c;
    __device__ bool next(int i, pg8::Unit& un) const { const int L = i * G + c; if (L >= 256) return false; const int b = L >> 7, rem = L & 127; un.row0 = rem & 15; un.pn = rem >> 4; un.pm = b * 16 + un.row0; un.e = b; return true; }
    __device__ __forceinline__ const char* a_base(const pg8::Unit& un) const { return (const char*)Dm + (size_t)un.row0 * 256 * 8192 * 2; }
    __device__ __forceinline__ const char* b_base(const pg8::Unit& un) const { return (const char*)ABt + ((size_t)un.e * 2048 + (size_t)un.pn * 256) * 8192 * 2; }
    __device__ __forceinline__ void a_offs(const pg8::Unit&, const int (&R)[2], const int (&C)[2], unsigned (&o)[2][2]) const {
#pragma unroll
        for (int h = 0; h < 2; ++h)
#pragma unroll
            for (int i = 0; i < 2; ++i) o[h][i] = (unsigned)((h * 128 + R[i]) * 8192 + C[i]) * 2u; }
};

constexpr int NPHASE = 18;
__global__ void __launch_bounds__(NTHR, 2) mk_fwd(Args a) {
    extern __shared__ __attribute__((aligned(16))) unsigned char lds_raw[];
    LAS unsigned char* lds = (LAS unsigned char*)lds_raw;
    unsigned char* ws = a.ws;
    volatile LAS unsigned* misc = (volatile LAS unsigned*)(lds + LDS_MISC);
    if (threadIdx.x < 4) misc[threadIdx.x] = 0u;
    __syncthreads();
    const int lo = a.ph_lo, hi = a.ph_hi;
    XcdBarrier bar; bar.bar = (unsigned*)(ws + WS_CTL) + CW_BAR; bar.x = 0; bar.st = misc;
    if (hi - lo > 1) bar = xcd_barrier_post((unsigned*)(ws + WS_CTL) + CW_BAR, misc);
#define IN(k) (lo <= (k) && (k) < hi)
#define SEAM(k) do { if (IN(k) && IN((k) + 1)) xcd_barrier(bar); } while (0)
    float* mod = (float*)(ws + WS_MOD); float* rot = (float*)(ws + WS_ROT);
    bf16_t* hbuf = (bf16_t*)(ws + WS_H); bf16_t* ybr = (bf16_t*)(ws + WS_Y); bf16_t* yb = (bf16_t*)(ws + WS_YB); bf16_t* act = (bf16_t*)(ws + WS_ACT);
    float* x1 = (float*)(ws + WS_X1); float* x2 = (float*)(ws + WS_X2); float* gw = (float*)(ws + WS_GW); int* list = (int*)(ws + WS_LIST);
    unsigned* cnt = (unsigned*)(ws + WS_CTL) + CW_CNT;
    LAS const int* tb = (LAS const int*)(lds + LDS_TB);
    const float* x = a.in[0]; const float* ln_g = a.in[9]; const float* ln_b = a.in[10];
    const int G = gridDim.x, cid = blockIdx.x;

    if (IN(0)) { p0_adaln(a, lds, mod); p0_tables(a, rot); p0_dft(lds, (bf16_t*)(ws + WS_DC), (bf16_t*)(ws + WS_DM)); p0_transposes(a, lds); }
    SEAM(0);
    if (IN(1)) { p_modulate(x, mod, hbuf); }
    SEAM(1);
    if (IN(2)) { pg8::PlainSched S; S.init(hbuf, (const bf16_t*)(ws + WS_WQKV), T, NQKV, D, G, cid);
        EpiQKV E{(bf16_t*)(ws + WS_QF), (bf16_t*)(ws + WS_KF), (bf16_t*)(ws + WS_VF), rot};
        pg8::gemm_phase<EpiQKV, pg8::PlainSched>(lds, D, S, E); }
    SEAM(2);
    if (IN(3)) { p_attention((const bf16_t*)(ws + WS_QF), (const bf16_t*)(ws + WS_KF), (const bf16_t*)(ws + WS_VF), (bf16_t*)(ws + WS_OG), (float*)(ws + WS_LSE)); }
    SEAM(3);
    if (IN(4)) { p_combine((const bf16_t*)(ws + WS_OG), (const float*)(ws + WS_LSE), (bf16_t*)(ws + WS_O)); }
    SEAM(4);
    if (IN(5)) { pg8::PlainSched S; S.init((const bf16_t*)(ws + WS_O), (const bf16_t*)(ws + WS_WO), T, D, D, G, cid); EpiBf16 E{ybr, D, 1.f, 0};
        pg8::gemm_phase<EpiBf16, pg8::PlainSched>(lds, D, S, E); }
    SEAM(5);
    if (IN(6)) { p_rows<1, true, false>(lds, x, ybr, ybr, mod, ln_g, ln_b, x1, mod + 1 * 12288, hbuf, a.in[11], a.in[12], a.in[13], a.in[14], gw, list, cnt); }
    SEAM(6);
    if (IN(7)) { moe_setup(lds, cnt);
        MoeSched S{tb, hbuf, (const bf16_t*)(ws + WS_WGU), list, D, D, 4, 2, 1024, G, cid, true}; EpiAct E{act};
        pg8::gemm_phase<EpiAct, MoeSched>(lds, D, S, E); }
    SEAM(7);
    if (IN(8)) { moe_setup(lds, cnt);
        MoeSched S{tb, act, (const bf16_t*)(ws + WS_WD), list, ED, ED, 8, 3, 2048, G, cid, false}; EpiDown E{tb, list, gw, yb};
        pg8::gemm_phase<EpiDown, MoeSched>(lds, ED, S, E); }
    SEAM(8);
    if (IN(9)) { p_rows<2, false, false>(lds, x1, yb, yb + (size_t)T * D, mod + 1 * 12288, ln_g + D, ln_b + D, x2, mod + 2 * 12288, hbuf, nullptr, nullptr, nullptr, nullptr, nullptr, nullptr, nullptr); }
    SEAM(9);
    if (IN(10)) { pg8::PlainSched S; S.init(hbuf, (const bf16_t*)(ws + WS_WIN), T, D, D, G, cid); EpiBf16 E{(bf16_t*)(ws + WS_U), D, 1.f, 0};
        pg8::gemm_phase<EpiBf16, pg8::PlainSched>(lds, D, S, E); }
    SEAM(10);
    if (IN(11)) { ChanSched S{(const bf16_t*)(ws + WS_DC), (const bf16_t*)(ws + WS_U), 512, 2048, G, cid}; EpiBf16 E{(bf16_t*)(ws + WS_ABT), 4096, 1.f, 1};
        pg8::gemm_phase<EpiBf16, ChanSched>(lds, 512, S, E); }
    SEAM(11);
    if (IN(12)) { SeqSched S{(const bf16_t*)(ws + WS_DM), (const bf16_t*)(ws + WS_ABT), 8192, 8192, G, cid}; EpiBf16 E{(bf16_t*)(ws + WS_YF), D, 6.9053396600248786e-4f, 0};
        pg8::gemm_phase<EpiBf16, SeqSched>(lds, 8192, S, E); }
    SEAM(12);
    if (IN(13)) { pg8::PlainSched S; S.init((const bf16_t*)(ws + WS_YF), (const bf16_t*)(ws + WS_WOUT), T, D, D, G, cid); EpiBf16 E{ybr, D, 1.f, 0};
        pg8::gemm_phase<EpiBf16, pg8::PlainSched>(lds, D, S, E); }
    SEAM(13);
    if (IN(14)) { p_rows<1, true, false>(lds, x2, ybr, ybr, mod + 2 * 12288, ln_g + 2 * D, ln_b + 2 * D, x1, mod + 3 * 12288, hbuf, a.in[11] + D * 4, a.in[12] + 4, a.in[13] + D * 32, a.in[14] + 32, gw, list, cnt + 32); }
    SEAM(14);
    if (IN(15)) { moe_setup(lds, cnt + 32);
        MoeSched S{tb, hbuf, (const bf16_t*)(ws + WS_WGU) + (size_t)32 * 1024 * 2048, list, D, D, 4, 2, 1024, G, cid, true}; EpiAct E{act};
        pg8::gemm_phase<EpiAct, MoeSched>(lds, D, S, E); }
    SEAM(15);
    if (IN(16)) { moe_setup(lds, cnt + 32);
        MoeSched S{tb, act, (const bf16_t*)(ws + WS_WD) + (size_t)32 * 2048 * 512, list, ED, ED, 8, 3, 2048, G, cid, false}; EpiDown E{tb, list, gw, yb};
        pg8::gemm_phase<EpiDown, MoeSched>(lds, ED, S, E); }
    SEAM(16);
    if (IN(17)) { p_rows<2, false, true>(lds, x1, yb, yb + (size_t)T * D, mod + 3 * 12288, ln_g + 3 * D, ln_b + 3 * D, a.out, nullptr, nullptr, nullptr, nullptr, nullptr, nullptr, nullptr, nullptr, nullptr); }
#undef IN
#undef SEAM
}

}

extern "C" void kernel_launch(void* const* d_in, const int* in_sizes, int n_in, void* d_out, int out_size, void* d_ws, size_t ws_size, hipStream_t stream) {
    (void)in_sizes; (void)n_in; (void)out_size; (void)ws_size;
    static bool attr = false;
    if (!attr) { (void)hipFuncSetAttribute((const void*)mk_fwd, hipFuncAttributeMaxDynamicSharedMemorySize, LDS_BYTES); attr = true; }
    (void)hipMemsetAsync((char*)d_ws + WS_CTL, 0, CTL_BYTES, stream);
    Args a{};
    for (int i = 0; i < 18; ++i) a.in[i] = (const float*)d_in[i];
    a.out = (float*)d_out; a.ws = (unsigned char*)d_ws;
    a.ph_lo = 0; a.ph_hi = NPHASE;
    hipLaunchKernelGGL(mk_fwd, dim3(256), dim3(NTHR), LDS_BYTES, stream, a);
}
```

```cpp
#include <hip/hip_runtime.h>
#include <stdint.h>

namespace {
constexpr int D = 2048, NB = 2, SEQ = 4096, T = NB * SEQ, NQKV = 18432, NE = 32, ED = 512;
constexpr float ALPHA = 1.41421356237309515f;
constexpr float LN_EPS = 1e-5f;

#define LAS __attribute__((address_space(3)))
typedef unsigned short bf16_t;
typedef short bf16x8 __attribute__((ext_vector_type(8)));
typedef float f32x4 __attribute__((ext_vector_type(4)));
typedef float f32x16 __attribute__((ext_vector_type(16)));
typedef unsigned u32x4 __attribute__((ext_vector_type(4)));
typedef unsigned u32x2 __attribute__((ext_vector_type(2)));

constexpr float QSCALE = 0.08838834764831845f * 1.4426950408889634f;
constexpr int NTHR = 512;
constexpr int LDS_BYTES = 147456;
constexpr int LDS_MISC = 131072;

constexpr size_t MB = 1024 * 1024;
constexpr size_t WS_CTL = 0;
constexpr size_t CTL_BYTES = 32768;
constexpr size_t WS_MOD = WS_CTL + CTL_BYTES;
constexpr size_t WS_ROT = WS_MOD + 196608;
constexpr size_t WS_LSE = WS_ROT + 1 * MB;
constexpr size_t WS_EID = WS_LSE + 1536 * 1024;
constexpr size_t WS_GW = WS_EID + 65536;
constexpr size_t WS_LIST = WS_GW + 65536;
constexpr size_t WS_DC = WS_LIST + 1 * MB;
constexpr size_t WS_WQKV = WS_DC + 1 * MB;
constexpr size_t WS_WO = WS_WQKV + (size_t)18432 * 2048 * 2;
constexpr size_t WS_WIN = WS_WO + 8 * MB;
constexpr size_t WS_WOUT = WS_WIN + 8 * MB;
constexpr size_t WS_WGU = WS_WOUT + 8 * MB;
constexpr size_t WS_WD = WS_WGU + 256 * MB;
constexpr size_t WS_H = WS_WD + 128 * MB;
constexpr size_t WS_O = WS_H + 32 * MB;
constexpr size_t WS_QF = WS_O + 32 * MB;
constexpr size_t WS_KF = WS_QF + 96 * MB;
constexpr size_t WS_VF = WS_KF + 96 * MB;
constexpr size_t WS_OG = WS_VF + 96 * MB;
constexpr size_t WS_FAST_END = WS_OG + 96 * MB;

constexpr int CW_BAR = 0;
constexpr int CW_CNT = 4096;

__device__ __forceinline__ unsigned pack_bf16(float lo, float hi) { unsigned r; asm("v_cvt_pk_bf16_f32 %0, %1, %2" : "=v"(r) : "v"(lo), "v"(hi)); return r; }
__device__ __forceinline__ float bf16_to_f32(bf16_t v) { return __uint_as_float(((unsigned)v) << 16); }
__device__ __forceinline__ int pi32(int x) { return (x & ~12) | ((x & 4) << 1) | ((x & 8) >> 1); }

__device__ __forceinline__ size_t tile_block(int g, int b, int head, int s, int& jo) {
    const int sh = g * 2;
    const int r = s & ((1 << sh) - 1), j = s >> sh, nbr = 128 >> sh;
    jo = j & 31;
    return (size_t)(((g * 2 + b) * 16 + head) * 128 + r * nbr + (j >> 5));
}
__device__ __forceinline__ size_t q_index(int g, int b, int head, int s, int d) { int jo; const size_t blk = tile_block(g, b, head, s, jo); const int c = d >> 3; return ((blk * 8 + (c >> 1)) * 64 + (c & 1) * 32 + jo) * 8 + (d & 7); }
__device__ __forceinline__ size_t k_index(int g, int b, int head, int s, int d) { int jo; const size_t blk = tile_block(g, b, head, s, jo); const int c = d >> 3; return ((blk * 8 + (c >> 1)) * 64 + (c & 1) * 32 + pi32(jo)) * 8 + (d & 7); }
__device__ __forceinline__ size_t v_index(int g, int b, int head, int s, int d) { int jo; const size_t blk = tile_block(g, b, head, s, jo); return ((blk * 8 + (d >> 5) * 2 + (jo >> 4)) * 64 + ((jo >> 3) & 1) * 32 + (d & 31)) * 8 + (jo & 7); }

#define XB_TMO      128
#define XB_XCNT(j)  (256  + 64 * (j))
#define XB_XSUB(j)  (1280 + 64 * (j))
#define XB_XGEN(j)  (2304 + 64 * (j))
#define XB_TOP      3328
#define XB_TOPGEN   3392
#define XCD_BAR_WORDS 3456
#define XB_SPIN_CAP (1u << 18)
__device__ __forceinline__ unsigned xb_ld(unsigned* p)              { return __hip_atomic_load(p, __ATOMIC_RELAXED, __HIP_MEMORY_SCOPE_AGENT); }
__device__ __forceinline__ unsigned xb_add(unsigned* p, unsigned v) { return __hip_atomic_fetch_add(p, v, __ATOMIC_RELAXED, __HIP_MEMORY_SCOPE_AGENT); }
__device__ __forceinline__ unsigned xb_xcc_id() { return (unsigned)__builtin_amdgcn_s_getreg((3 << 11) | 20) & 0xFu; }
#define XB_SPIN(cond, bar) do { unsigned _sp = 0; while (cond) { __builtin_amdgcn_s_sleep(1); \
    if ((++_sp & 255u) == 0u) { if (xb_ld(&(bar)[XB_TMO])) break; if (_sp > XB_SPIN_CAP) { atomicAdd(&(bar)[XB_TMO], 1u); break; } } } } while (0)
struct XcdBarrier { unsigned* bar; unsigned x; volatile LAS unsigned* st; };
__device__ __forceinline__ XcdBarrier xcd_barrier_post(unsigned* bar, volatile LAS unsigned* st) {
    XcdBarrier b; b.bar = bar; b.x = xb_xcc_id(); b.st = st;
    if (threadIdx.x == 0) (void)xb_add(&bar[XB_XCNT(b.x)], 1u);
    return b;
}
__device__ __forceinline__ void xcd_barrier_complete(unsigned* bar, unsigned x, unsigned& nloc, unsigned& nx) {
    const unsigned G = gridDim.x * gridDim.y * gridDim.z;
    unsigned sum, cnt, mine, sp = 0u;
    for (;;) {
        sum = 0u; cnt = 0u; mine = 0u;
#pragma unroll
        for (unsigned j = 0; j < 16; ++j) { const unsigned c = xb_ld(&bar[XB_XCNT(j)]); sum += c; cnt += (c > 0u) ? 1u : 0u; mine = (j == x) ? c : mine; }
        if (sum == G) break;
        __builtin_amdgcn_s_sleep(1);
        if ((++sp & 255u) == 0u) { if (xb_ld(&bar[XB_TMO])) break; if (sp > XB_SPIN_CAP) { atomicAdd(&bar[XB_TMO], 1u); break; } }
    }
    nloc = mine > 0u ? mine : 1u; nx = cnt > 0u ? cnt : 1u;
}
__device__ __forceinline__ void xcd_barrier(const XcdBarrier& b) {
    asm volatile("s_waitcnt vmcnt(0)" ::: "memory");
    __syncthreads();
    if (threadIdx.x == 0) {
        unsigned* bar = b.bar;
        __builtin_amdgcn_s_waitcnt(0);
        unsigned nloc = b.st[0], nx = b.st[1];
        if (nloc == 0u) { xcd_barrier_complete(bar, b.x, nloc, nx); b.st[0] = nloc; b.st[1] = nx; }
        const unsigned old = xb_add(&bar[XB_XSUB(b.x)], 1u);
        const unsigned gen = old / nloc;
        if (old + 1u == (gen + 1u) * nloc) {
            __builtin_amdgcn_fence(__ATOMIC_RELEASE, "agent");
            asm volatile("s_waitcnt vmcnt(0)" ::: "memory");
            const unsigned og = xb_add(&bar[XB_TOP], 1u);
            const unsigned tg = og / nx;
            if (og + 1u == (tg + 1u) * nx) xb_add(&bar[XB_TOPGEN], 1u);
            else XB_SPIN(xb_ld(&bar[XB_TOPGEN]) == tg, bar);
            __builtin_amdgcn_fence(__ATOMIC_ACQUIRE, "agent");
            xb_add(&bar[XB_XGEN(b.x)], 1u);
            asm volatile("s_waitcnt vmcnt(0)" ::: "memory");
        } else {
            XB_SPIN(xb_ld(&bar[XB_XGEN(b.x)]) == gen, bar);
            __builtin_amdgcn_fence(__ATOMIC_ACQUIRE, "agent");
            asm volatile("s_waitcnt vmcnt(0)" ::: "memory");
        }
    }
    __syncthreads();
}

namespace pg8 {
constexpr int BM = 256, BK = 64, HALF = 128, HTB = HALF * BK * 2, STAGE_BYTES = 8 * HTB, NXCD = 8, WGM = 8;
__host__ __device__ __forceinline__ int lds_byte(int r, int c) { const int st = (r >> 4) * 2 + (c >> 5), rr = r & 15, cc = c & 31, ob = rr * 64 + cc * 2; return st * 1024 + (ob ^ (((ob >> 9) & 1) << 5)); }
__host__ __device__ __forceinline__ void stage_rc(int b, int& R, int& C) { const int st = b / 1024, sb = b % 1024, swz = sb ^ (((sb >> 9) & 1) << 5); R = (st >> 1) * 16 + swz / 64; C = (st & 1) * 32 + (swz % 64) / 2; }
__host__ __device__ __forceinline__ int perm32(int rho) { const int n = rho >> 4, i = rho & 15; return 8 * (i >> 2) + 4 * n + (i & 3); }

struct Unit { int pm, pn, e, row0; };

struct PlainSched {
    static constexpr bool A_INV = true, B_INV = true;
    const bf16_t* A; const bf16_t* Bt; int K, ldb; int nM, nN, nwg, G, c;
    __device__ void init(const bf16_t* A_, const bf16_t* Bt_, int M, int N, int K_, int G_, int c_) { A = A_; Bt = Bt_; K = K_; ldb = K_; nM = M / BM; nN = N / BM; nwg = nM * nN; G = G_; c = c_; }
    __device__ bool next(int i, Unit& u) const {
        const long L = (long)i * G + c; if (L >= nwg) return false;
        int wgid = (int)L; { const int q = nwg / NXCD, r = nwg % NXCD, xcd = wgid % NXCD, off = wgid / NXCD; wgid = (xcd < r ? xcd * (q + 1) : r * (q + 1) + (xcd - r) * q) + off; }
        const int nig = WGM * nN, gid = wgid / nig, fm = gid * WGM, gsz = (nM - fm) < WGM ? (nM - fm) : WGM;
        u.pm = fm + ((wgid % nig) % gsz); u.pn = (wgid % nig) / gsz; u.e = 0; u.row0 = 0; return true;
    }
    __device__ __forceinline__ const char* a_base(const Unit& u) const { return (const char*)A + (size_t)u.pm * BM * K * 2; }
    __device__ __forceinline__ const char* b_base(const Unit& u) const { return (const char*)Bt + (size_t)u.pn * BM * K * 2; }
    __device__ __forceinline__ void a_offs(const Unit&, const int (&R)[2], const int (&C)[2], unsigned (&o)[2][2]) const {
#pragma unroll
        for (int h = 0; h < 2; ++h)
#pragma unroll
            for (int i = 0; i < 2; ++i) o[h][i] = (unsigned)((h * HALF + R[i]) * K + C[i]) * 2u;
    }
    __device__ __forceinline__ void b_offs(const Unit&, const int (&R)[2], const int (&C)[2], unsigned (&o)[2][2]) const {
#pragma unroll
        for (int h = 0; h < 2; ++h)
#pragma unroll
            for (int i = 0; i < 2; ++i) o[h][i] = (unsigned)((h * HALF + (R[i] & ~31) + perm32(R[i] & 31)) * ldb + C[i]) * 2u;
    }
    __device__ __forceinline__ unsigned kstepA() const { return 128u; }
    __device__ __forceinline__ unsigned kstepB() const { return 128u; }
};

template <class Epi, class Sched, bool ONE_TRIP = false>
__device__ __forceinline__ void gemm_phase(LAS unsigned char* lds, const int K, const Sched& S, const Epi& E) {
    int tid_ = threadIdx.x; asm volatile("" : "+v"(tid_));
    const int tid = tid_, wid = __builtin_amdgcn_readfirstlane(tid >> 6), lane = tid & 63, wr = wid >> 2, wc = wid & 3, fr = lane & 15, fq = lane >> 4;
    const int nt = K / BK;
    int sR[2], sC[2];
#pragma unroll
    for (int i = 0; i < 2; ++i) stage_rc(tid * 16 + i * 8192, sR[i], sC[i]);
    const size_t kA = S.kstepA(), kB = S.kstepB();
    const unsigned ldsw = (unsigned)wid * 1024u;
    const int aoff = lds_byte(wr * 64 + fr, fq * 8), boff = lds_byte(wc * 32 + fr, fq * 8);
#define PG8_SA(b, h) (((b) * 2 + (h)) * HTB)
#define PG8_SB(b, h) ((4 + (b) * 2 + (h)) * HTB)
#define PG8_GLDS(src, dstoff) __builtin_amdgcn_global_load_lds((const unsigned*)(src), (LAS unsigned*)(lds + (dstoff)), 16, 0, 0)
#define PG8_STAGE(bufoff, gbase, o0, o1) do { PG8_GLDS((const char*)(gbase) + (o0), (bufoff) + ldsw); PG8_GLDS((const char*)(gbase) + (o1), (bufoff) + ldsw + 8192); } while (0)
#define PG8_LDA(dst, b, h) do { _Pragma("unroll") for (int m = 0; m < 4; ++m) _Pragma("unroll") for (int k = 0; k < 2; ++k) dst[m][k] = *(const LAS bf16x8*)(lds + PG8_SA(b, h) + aoff + m * 2048 + k * 1024); } while (0)
#define PG8_LDB(dst, b, h) do { _Pragma("unroll") for (int n = 0; n < 2; ++n) _Pragma("unroll") for (int k = 0; k < 2; ++k) dst[n][k] = *(const LAS bf16x8*)(lds + PG8_SB(b, h) + boff + n * 2048 + k * 1024); } while (0)
#define PG8_MMA(ai, bj, At, Bt) do { __builtin_amdgcn_s_setprio(1); _Pragma("unroll") for (int m = 0; m < 4; ++m) _Pragma("unroll") for (int n = 0; n < 2; ++n) _Pragma("unroll") for (int k = 0; k < 2; ++k) \
        acc[ai][bj][m][n] = __builtin_amdgcn_mfma_f32_16x16x32_bf16(Bt[n][k], At[m][k], acc[ai][bj][m][n], 0, 0, 0); __builtin_amdgcn_s_setprio(0); } while (0)
#define PG8_WAIT_V(n) asm volatile("s_waitcnt vmcnt(" #n ")" ::: "memory")
#define PG8_WAIT_L(n) asm volatile("s_waitcnt lgkmcnt(" #n ")" ::: "memory")
#define PG8_BAR __builtin_amdgcn_s_barrier()
#define PG8_SCHED __builtin_amdgcn_sched_barrier(0)
    Unit cur, nxt; int ui = 0;
    if (!S.next(0, cur)) return;
    f32x4 acc[2][2][4][2];
#pragma unroll
    for (int a = 0; a < 2; ++a)
#pragma unroll
        for (int b = 0; b < 2; ++b)
#pragma unroll
            for (int m = 0; m < 4; ++m)
#pragma unroll
                for (int n = 0; n < 2; ++n) acc[a][b][m][n] = (f32x4){0.f, 0.f, 0.f, 0.f};
    bf16x8 At[4][2], B0[2][2], B1[2][2];
    unsigned vc[2][2], wc_[2][2];
    S.a_offs(cur, sR, sC, vc); S.b_offs(cur, sR, sC, wc_);
    const char* cA = S.a_base(cur); const char* cB = S.b_base(cur);
    PG8_STAGE(PG8_SB(0, 0), cB, wc_[0][0], wc_[0][1]); PG8_STAGE(PG8_SB(0, 1), cB, wc_[1][0], wc_[1][1]); PG8_STAGE(PG8_SA(0, 0), cA, vc[0][0], vc[0][1]); PG8_STAGE(PG8_SA(0, 1), cA, vc[1][0], vc[1][1]);
    if (wr == 1) PG8_BAR;
    PG8_WAIT_V(2); PG8_BAR;
    PG8_STAGE(PG8_SB(1, 0), cB + kB, wc_[0][0], wc_[0][1]); PG8_STAGE(PG8_SA(1, 0), cA + kA, vc[0][0], vc[0][1]); PG8_STAGE(PG8_SB(1, 1), cB + kB, wc_[1][0], wc_[1][1]);
    PG8_WAIT_V(6); PG8_BAR;
#define PG8_TRIP(a1, a2, a3, b2, b3, C10, C11, N00, N01, N10, N11, M00, M01, M10, M11) do { \
              \
            PG8_LDB(B0, 0, 0); PG8_LDB(B1, 0, 1); PG8_SCHED; PG8_LDA(At, 0, 0); PG8_STAGE(PG8_SA(1, 1), a1, C10, C11); \
            PG8_WAIT_V(8); PG8_WAIT_L(0); PG8_BAR; PG8_MMA(0, 0, At, B0); PG8_MMA(0, 1, At, B1); PG8_BAR; PG8_SCHED; \
              \
            PG8_LDA(At, 0, 1); PG8_STAGE(PG8_SB(0, 0), b2, M00, M01); PG8_STAGE(PG8_SB(0, 1), b2, M10, M11); PG8_STAGE(PG8_SA(0, 0), a2, N00, N01); \
            PG8_WAIT_V(8); PG8_WAIT_L(0); PG8_BAR; PG8_MMA(1, 0, At, B0); PG8_MMA(1, 1, At, B1); PG8_BAR; PG8_SCHED; \
              \
            PG8_LDB(B0, 1, 0); PG8_LDB(B1, 1, 1); PG8_SCHED; PG8_LDA(At, 1, 0); PG8_STAGE(PG8_SA(0, 1), a2, N10, N11); \
            PG8_WAIT_V(8); PG8_WAIT_L(0); PG8_BAR; PG8_MMA(0, 0, At, B0); PG8_MMA(0, 1, At, B1); PG8_BAR; PG8_SCHED; \
              \
            PG8_LDA(At, 1, 1); PG8_STAGE(PG8_SB(1, 0), b3, M00, M01); PG8_STAGE(PG8_SB(1, 1), b3, M10, M11); PG8_STAGE(PG8_SA(1, 0), a3, N00, N01); \
            PG8_WAIT_V(8); PG8_WAIT_L(0); PG8_BAR; PG8_MMA(1, 0, At, B0); PG8_MMA(1, 1, At, B1); PG8_BAR; PG8_SCHED; } while (0)
    unsigned vn[2][2], wn_[2][2];
#pragma unroll
    for (int h = 0; h < 2; ++h) { vn[h][0] = vc[h][0]; vn[h][1] = vc[h][1]; wn_[h][0] = wc_[h][0]; wn_[h][1] = wc_[h][1]; }
    for (;;) {
        const bool has_next = S.next(ui + 1, nxt);
        const char* nA = has_next ? S.a_base(nxt) : cA; const char* nB = has_next ? S.b_base(nxt) : cB;
        if constexpr (ONE_TRIP) {
            if (has_next) { if constexpr (!Sched::A_INV) S.a_offs(nxt, sR, sC, vn); if constexpr (!Sched::B_INV) S.b_offs(nxt, sR, sC, wn_); }
            PG8_TRIP(cA + kA, nA, nA + kA, nB, nB + kB, vc[1][0], vc[1][1], vn[0][0], vn[0][1], vn[1][0], vn[1][1], wn_[0][0], wn_[0][1], wn_[1][0], wn_[1][1]);
        } else {
            for (int t = 0; t < nt; t += 2) {
                const bool last = (t == nt - 2);
                if (last && has_next) { if constexpr (!Sched::A_INV) S.a_offs(nxt, sR, sC, vn); if constexpr (!Sched::B_INV) S.b_offs(nxt, sR, sC, wn_); }
                const char* a1 = cA + (size_t)(t + 1) * kA;
                const char* a2 = last ? nA : cA + (size_t)(t + 2) * kA; const char* b2 = last ? nB : cB + (size_t)(t + 2) * kB;
                const char* a3 = a2 + kA; const char* b3 = b2 + kB;
                const bool la = last && !Sched::A_INV, lb = last && !Sched::B_INV;
                const unsigned x00 = la ? vn[0][0] : vc[0][0], x01 = la ? vn[0][1] : vc[0][1], x10 = la ? vn[1][0] : vc[1][0], x11 = la ? vn[1][1] : vc[1][1];
                const unsigned y00 = lb ? wn_[0][0] : wc_[0][0], y01 = lb ? wn_[0][1] : wc_[0][1], y10 = lb ? wn_[1][0] : wc_[1][0], y11 = lb ? wn_[1][1] : wc_[1][1];
                PG8_TRIP(a1, a2, a3, b2, b3, vc[1][0], vc[1][1], x00, x01, x10, x11, y00, y01, y10, y11);
            }
        }
#pragma unroll
        for (int h = 0; h < 2; ++h) { vc[h][0] = vn[h][0]; vc[h][1] = vn[h][1]; wc_[h][0] = wn_[h][0]; wc_[h][1] = wn_[h][1]; }
        if (wr == 0) PG8_BAR;
        E(acc, cur, wr, wc, fr, fq);
        if (!has_next) break;
#pragma unroll
        for (int a = 0; a < 2; ++a)
#pragma unroll
            for (int b = 0; b < 2; ++b)
#pragma unroll
                for (int m = 0; m < 4; ++m)
#pragma unroll
                    for (int n = 0; n < 2; ++n) acc[a][b][m][n] = (f32x4){0.f, 0.f, 0.f, 0.f};
        cur = nxt; cA = nA; cB = nB; ++ui;
        if (wr == 1) PG8_BAR;
    }
    PG8_WAIT_V(0);
    PG8_BAR;
#undef PG8_SA
#undef PG8_SB
#undef PG8_GLDS
#undef PG8_STAGE
#undef PG8_TRIP
#undef PG8_LDA
#undef PG8_LDB
#undef PG8_MMA
#undef PG8_WAIT_V
#undef PG8_WAIT_L
#undef PG8_BAR
#undef PG8_SCHED
}
}

struct Args { const float* in[18]; float* out; unsigned char* ws; int ph_lo, ph_hi, rep, pad; };

__device__ __forceinline__ void p0_adaln(const Args& a, LAS unsigned char* lds, float* mod) {
    const int tid = threadIdx.x;
    LAS float* sc = (LAS float*)lds;
    LAS float* red = (LAS float*)(lds + 16384);
    const float* c = a.in[1]; const float* ada_w = a.in[3]; const float* ada_b = a.in[4];
    for (int i = tid; i < 4096; i += NTHR) { const float v = c[i]; sc[i] = v / (1.f + expf(-v)); }
    __syncthreads();
    const int r = tid / 24, c4 = tid % 24;
    for (int cg = blockIdx.x; cg < 256; cg += gridDim.x) {
        const int idx = cg >> 6, col0 = (cg & 63) * 96;
        const float* W = ada_w + (size_t)idx * 2048 * 6144 + col0 + c4 * 4;
        f32x4 a0 = {0.f, 0.f, 0.f, 0.f}, a1 = {0.f, 0.f, 0.f, 0.f};
        if (tid < 504) {
            int k = r;
            for (; k + 63 < 2048; k += 84) {
                const f32x4 w0 = *(const f32x4*)(W + (size_t)k * 6144), w1 = *(const f32x4*)(W + (size_t)(k + 21) * 6144), w2 = *(const f32x4*)(W + (size_t)(k + 42) * 6144), w3 = *(const f32x4*)(W + (size_t)(k + 63) * 6144);
                a0 += sc[k] * w0; a1 += sc[2048 + k] * w0; a0 += sc[k + 21] * w1; a1 += sc[2048 + k + 21] * w1;
                a0 += sc[k + 42] * w2; a1 += sc[2048 + k + 42] * w2; a0 += sc[k + 63] * w3; a1 += sc[2048 + k + 63] * w3;
            }
            for (; k < 2048; k += 21) { const f32x4 w0 = *(const f32x4*)(W + (size_t)k * 6144); a0 += sc[k] * w0; a1 += sc[2048 + k] * w0; }
            *(LAS f32x4*)(red + (r * 24 + c4) * 8) = a0; *(LAS f32x4*)(red + (r * 24 + c4) * 8 + 4) = a1;
        }
        __syncthreads();
        if (tid < 192) {
            const int cc4 = tid >> 3, j = tid & 7; float s = 0.f;
            for (int rr = 0; rr < 21; ++rr) s += red[(rr * 24 + cc4) * 8 + j];
            const int b = j >> 2, col = col0 + cc4 * 4 + (j & 3);
            mod[(idx * 2 + b) * 6144 + col] = s + ada_b[idx * 6144 + col];
        }
        __syncthreads();
    }
}

struct TJob { const float* src; bf16_t* dst; int K, N, rowmode; };
__device__ __forceinline__ void p0_transpose_tile(const TJob& j, int tk, int tn, LAS unsigned* T2, int tid) {
    const int k0 = tk * 128, n0 = tn * 64;
    f32x4 f[2][2];
#pragma unroll
    for (int i = 0; i < 2; ++i) { const int p = i * 32 + (tid >> 4), c = (tid & 15) * 4;
        f[i][0] = *(const f32x4*)(j.src + (size_t)(k0 + 2 * p) * j.N + n0 + c); f[i][1] = *(const f32x4*)(j.src + (size_t)(k0 + 2 * p + 1) * j.N + n0 + c); }
    __syncthreads();
#pragma unroll
    for (int i = 0; i < 2; ++i) { const int p = i * 32 + (tid >> 4), c = (tid & 15) * 4;
#pragma unroll
        for (int e = 0; e < 4; ++e) T2[p * 65 + c + e] = pack_bf16(f[i][0][e], f[i][1][e]); }
    __syncthreads();
    const int n = tid >> 3, x = tid & 7;
    unsigned d[8];
#pragma unroll
    for (int jj = 0; jj < 8; ++jj) d[jj] = T2[(8 * x + jj) * 65 + n];
    const int nn = n0 + n;
    const int row = j.rowmode == 0 ? nn : ((nn >> 4) * 32 + (nn & 15) + (j.rowmode == 2 ? 16 : 0));
    bf16_t* dp = j.dst + (size_t)row * j.K + k0 + 16 * x;
    *(u32x4*)dp = (u32x4){d[0], d[1], d[2], d[3]}; *(u32x4*)(dp + 8) = (u32x4){d[4], d[5], d[6], d[7]};
}
__device__ __forceinline__ void p0_transposes(const Args& a, LAS unsigned char* lds) {
    const int tid = threadIdx.x; LAS unsigned* T2 = (LAS unsigned*)lds;
    unsigned char* ws = a.ws;
    for (int t = blockIdx.x; t < 30720; t += gridDim.x) {
        TJob j; int tk, tn;
        if (t < 4608) { j = TJob{a.in[5], (bf16_t*)(ws + WS_WQKV), 2048, 18432, 0}; tk = t / 288; tn = t % 288; }
        else if (t < 6144) { const int q = t - 4608, w = q / 512, r = q % 512; j = TJob{a.in[6 + w], (bf16_t*)(ws + (w == 0 ? WS_WO : (w == 1 ? WS_WIN : WS_WOUT))), 2048, 2048, 0}; tk = r / 32; tn = r % 32; }
        else if (t < 22528) { const int q = t - 6144, up = q / 8192, r = q % 8192, mat = r / 128, rr = r % 128;
            j = TJob{a.in[15 + up] + (size_t)mat * 2048 * 512, (bf16_t*)(ws + WS_WGU) + (size_t)mat * 1024 * 2048, 2048, 512, 1 + up}; tk = rr / 8; tn = rr % 8; }
        else { const int r = t - 22528, mat = r / 128, rr = r % 128; j = TJob{a.in[17] + (size_t)mat * 512 * 2048, (bf16_t*)(ws + WS_WD) + (size_t)mat * 2048 * 512, 512, 2048, 0}; tk = rr / 32; tn = rr % 32; }
        p0_transpose_tile(j, tk, tn, T2, tid);
    }
    __syncthreads();
}
__device__ __forceinline__ void p0_tables(const Args& a, float* rot) {
    const int* pos = (const int*)a.in[2];
    for (int i = blockIdx.x * NTHR + threadIdx.x; i < T * 16; i += gridDim.x * NTHR) {
        const int t = i >> 4, j = i & 15;
        const float invf = (float)pow(500000.0, -(double)j / 16.0);
        const float ang = (float)pos[t] * invf;
        double r = (double)ang * 0.31830988618379067154; r -= 2.0 * rint(r * 0.5);
        float s, c; sincospif((float)r, &s, &c);
        rot[t * 32 + j] = c; rot[t * 32 + 16 + j] = s;
    }
}
__device__ __forceinline__ void p_modulate(const float* __restrict__ x, const float* __restrict__ mod, bf16_t* __restrict__ h) {
    for (size_t i = (size_t)blockIdx.x * NTHR + threadIdx.x; i < (size_t)T * D / 8; i += (size_t)gridDim.x * NTHR) {
        const size_t e = i * 8; const int t = (int)(e >> 11), d = (int)(e & 2047), b = t >> 12;
        const f32x4 x0 = *(const f32x4*)(x + e), x1 = *(const f32x4*)(x + e + 4);
        const float* m = mod + b * 6144 + d;
        const f32x4 sh0 = *(const f32x4*)m, sh1 = *(const f32x4*)(m + 4), sc0 = *(const f32x4*)(m + 2048), sc1 = *(const f32x4*)(m + 2052);
        const f32x4 y0 = x0 * (1.f + sc0) + sh0, y1 = x1 * (1.f + sc1) + sh1;
        *(u32x4*)(h + e) = (u32x4){pack_bf16(y0[0], y0[1]), pack_bf16(y0[2], y0[3]), pack_bf16(y1[0], y1[1]), pack_bf16(y1[2], y1[3])};
    }
}
struct QkvSched {
    static constexpr bool A_INV = true, B_INV = false;
    const unsigned char* ws; int G, c;
    __device__ static void grid_map(int wgid, int nM, int nN, int& pm, int& pn) {
        const int nwg = nM * nN; { const int q = nwg / pg8::NXCD, r = nwg % pg8::NXCD, xcd = wgid % pg8::NXCD, off = wgid / pg8::NXCD; wgid = (xcd < r ? xcd * (q + 1) : r * (q + 1) + (xcd - r) * q) + off; }
        const int nig = pg8::WGM * nN, gid = wgid / nig, fm = gid * pg8::WGM, gsz = (nM - fm) < pg8::WGM ? (nM - fm) : pg8::WGM;
        pm = fm + ((wgid % nig) % gsz); pn = (wgid % nig) / gsz;
    }
    __device__ bool next(int i, pg8::Unit& u) const {
        const int L = i * G + c; if (L >= 2304) return false;
        if (L < 1536) { grid_map(L, 32, 48, u.pm, u.pn); u.e = 0; const int g = u.pn >> 4, which = (u.pn >> 3) & 1; u.row0 = g * 6144 + which * 2048 + (u.pn & 7) * 256; }
        else { grid_map(L - 1536, 24, 32, u.pm, u.pn); u.e = 1; const int g = u.pm >> 3; u.row0 = g * 6144 + 4096 + (u.pm & 7) * 256; }
        return true;
    }
    __device__ __forceinline__ const char* a_base(const pg8::Unit& u) const { return (const char*)ws + (u.e == 0 ? WS_H + (size_t)u.pm * 256 * 2048 * 2 : WS_WQKV + (size_t)u.row0 * 2048 * 2); }
    __device__ __forceinline__ const char* b_base(const pg8::Unit& u) const { return (const char*)ws + (u.e == 0 ? WS_WQKV + (size_t)u.row0 * 2048 * 2 : WS_H); }
    __device__ __forceinline__ void a_offs(const pg8::Unit&, const int (&R)[2], const int (&C)[2], unsigned (&o)[2][2]) const {
#pragma unroll
        for (int h = 0; h < 2; ++h)
#pragma unroll
            for (int i = 0; i < 2; ++i) o[h][i] = (unsigned)((h * 128 + R[i]) * 2048 + C[i]) * 2u; }
    __device__ __forceinline__ void b_offs(const pg8::Unit& u, const int (&R)[2], const int (&C)[2], unsigned (&o)[2][2]) const {
        const int sh = (u.pm >> 3) * 2;
#pragma unroll
        for (int h = 0; h < 2; ++h)
#pragma unroll
            for (int i = 0; i < 2; ++i) {
                if (u.e == 0) o[h][i] = (unsigned)((h * 128 + R[i]) * 2048 + C[i]) * 2u;
                else { const int n = (u.pn & 15) * 256 + h * 128 + (R[i] & ~31) + pg8::perm32(R[i] & 31);
                    const int lg = 12 - sh, r = n >> lg, j = n & ((1 << lg) - 1), t = (u.pn >> 4) * 4096 + r + (j << sh); o[h][i] = (unsigned)(t * 2048 + C[i]) * 2u; }
            } }
    __device__ __forceinline__ unsigned kstepA() const { return 128u; }
    __device__ __forceinline__ unsigned kstepB() const { return 128u; }
};
struct EpiQKV {
    bf16_t* Qf; bf16_t* Kf; bf16_t* Vf; const float* rot;
    __device__ __forceinline__ void operator()(const f32x4 (&acc)[2][2][4][2], const pg8::Unit& u, int wr, int wc, int fr_, int fq_) const {
        int fr = fr_, fq = fq_; asm volatile("" : "+v"(fr), "+v"(fq));
        if (u.e == 0) {
            const int g = u.pn >> 4, which = (u.pn >> 3) & 1, head0 = (u.pn & 7) * 2, sh = g * 2, nbr = 128 >> sh;
            bf16_t* dst = Qf + (size_t)which * ((WS_KF - WS_QF) / 2);
#pragma unroll
            for (int ai = 0; ai < 2; ++ai)
#pragma unroll
                for (int m = 0; m < 4; ++m) {
                    const int row = u.pm * 256 + ai * 128 + wr * 64 + m * 16 + fr, b = row >> 12, s = row & 4095;
                    const int r = s & ((1 << sh) - 1), j = s >> sh, jo = j & 31, blk = r * nbr + (j >> 5);
                    f32x4 cs = {1.f, 1.f, 1.f, 1.f}, sn = {0.f, 0.f, 0.f, 0.f};
                    if (wc == 0) { const float* rp = rot + (size_t)row * 32 + 4 * fq; cs = *(const f32x4*)rp; sn = *(const f32x4*)(rp + 16); }
                    const int c = 4 * wc + fq, ks = c >> 1, hh = c & 1, lanepos = which == 0 ? jo : pi32(jo);
#pragma unroll
                    for (int bj = 0; bj < 2; ++bj) {
                        const size_t blkid = (size_t)(((g * 2 + b) * 16 + head0 + bj) * 128 + blk);
                        f32x4 v0 = acc[ai][bj][m][0], v1 = acc[ai][bj][m][1];
                        if (wc == 0) { const f32x4 t0 = v0 * cs - v1 * sn, t1 = v1 * cs + v0 * sn; v0 = t0; v1 = t1; }
                        if (which == 0) { v0 *= QSCALE; v1 *= QSCALE; }
                        *(u32x4*)(dst + ((blkid * 8 + ks) * 64 + hh * 32 + lanepos) * 8) = (u32x4){pack_bf16(v0[0], v0[1]), pack_bf16(v0[2], v0[3]), pack_bf16(v1[0], v1[1]), pack_bf16(v1[2], v1[3])};
                    }
                }
        } else {
            const int g = u.pm >> 3, sh = g * 2, nbr = 128 >> sh, lg = 12 - sh, b = u.pn >> 4;
#pragma unroll
            for (int bj = 0; bj < 2; ++bj) {
                const int n0 = (u.pn & 15) * 256 + bj * 128 + wc * 32 + 8 * fq, r = n0 >> lg, j0 = n0 & ((1 << lg) - 1), jo = j0 & 31, blk = r * nbr + (j0 >> 5);
#pragma unroll
                for (int ai = 0; ai < 2; ++ai)
#pragma unroll
                    for (int m = 0; m < 4; ++m) {
                        const int f = (u.pm & 7) * 256 + ai * 128 + wr * 64 + m * 16 + fr, head = f >> 7, d = f & 127;
                        const size_t blkid = (size_t)(((g * 2 + b) * 16 + head) * 128 + blk);
                        const f32x4 v0 = acc[ai][bj][m][0], v1 = acc[ai][bj][m][1];
                        *(u32x4*)(Vf + ((blkid * 8 + (d >> 5) * 2 + (jo >> 4)) * 64 + ((jo >> 3) & 1) * 32 + (d & 31)) * 8) = (u32x4){pack_bf16(v0[0], v0[1]), pack_bf16(v0[2], v0[3]), pack_bf16(v1[0], v1[1]), pack_bf16(v1[2], v1[3])};
                    }
            }
        }
    }
};

__device__ __forceinline__ void p_attention(const bf16_t* __restrict__ Qf, const bf16_t* __restrict__ Kf, const bf16_t* __restrict__ Vf, bf16_t* __restrict__ og, float* __restrict__ lse) {
    const int lane = threadIdx.x & 63, wave = __builtin_amdgcn_readfirstlane(threadIdx.x >> 6);
    const int qo = lane & 31, hh = lane >> 5;
    const int nwaves = gridDim.x * 8, wg = blockIdx.x * 8 + wave;
    for (int item = wg; item < 3 * 4096; item += nwaves) {
        const int g = item >> 12, rem = item & 4095, b = rem >> 11, head = (rem >> 7) & 15, blk = rem & 127;
        const int sh = g * 2, nbr = 128 >> sh, r = blk / nbr, jb = blk % nbr;
        const size_t base = (size_t)(((g * 2 + b) * 16 + head) * 128);
        bf16x8 qf[8];
#pragma unroll
        for (int ks = 0; ks < 8; ++ks) qf[ks] = *(const bf16x8*)(Qf + (((base + blk) * 8 + ks) * 64 + lane) * 8);
        f32x16 O[4];
#pragma unroll
        for (int db = 0; db < 4; ++db)
#pragma unroll
            for (int e = 0; e < 16; ++e) O[db][e] = 0.f;
        float m = -1e30f, l = 0.f;
        for (int kb = jb - 2; kb <= jb + 2; ++kb) {
            if (kb < 0 || kb >= nbr) continue;
            const size_t kblk = base + r * nbr + kb;
            bf16x8 kf[8], vf[8];
#pragma unroll
            for (int ks = 0; ks < 8; ++ks) kf[ks] = *(const bf16x8*)(Kf + ((kblk * 8 + ks) * 64 + lane) * 8);
#pragma unroll
            for (int ks = 0; ks < 8; ++ks) vf[ks] = *(const bf16x8*)(Vf + ((kblk * 8 + ks) * 64 + lane) * 8);
            f32x16 S;
#pragma unroll
            for (int e = 0; e < 16; ++e) S[e] = 0.f;
#pragma unroll
            for (int ks = 0; ks < 8; ++ks) S = __builtin_amdgcn_mfma_f32_32x32x16_bf16(kf[ks], qf[ks], S, 0, 0, 0);
            if (kb == jb - 2) {
#pragma unroll
                for (int e = 0; e < 16; ++e) { const int ko = 16 * (e >> 3) + 8 * hh + (e & 7); if (ko < qo) S[e] = -1e30f; }
            }
            if (kb == jb + 2) {
#pragma unroll
                for (int e = 0; e < 16; ++e) { const int ko = 16 * (e >> 3) + 8 * hh + (e & 7); if (ko > qo) S[e] = -1e30f; }
            }
            float bm = S[0];
#pragma unroll
            for (int e = 1; e < 16; ++e) bm = fmaxf(bm, S[e]);
            bm = fmaxf(bm, __shfl_xor(bm, 32));
            const float mn = fmaxf(m, bm), alpha = exp2f(m - mn);
            float ls = 0.f;
#pragma unroll
            for (int e = 0; e < 16; ++e) { S[e] = exp2f(S[e] - mn); ls += S[e]; }
            l = l * alpha + ls; m = mn;
#pragma unroll
            for (int db = 0; db < 4; ++db)
#pragma unroll
                for (int e = 0; e < 16; ++e) O[db][e] *= alpha;
            bf16x8 pf[2];
#pragma unroll
            for (int s2 = 0; s2 < 2; ++s2) { u32x4 w = {pack_bf16(S[8 * s2], S[8 * s2 + 1]), pack_bf16(S[8 * s2 + 2], S[8 * s2 + 3]), pack_bf16(S[8 * s2 + 4], S[8 * s2 + 5]), pack_bf16(S[8 * s2 + 6], S[8 * s2 + 7])};
                pf[s2] = __builtin_bit_cast(bf16x8, w); }
#pragma unroll
            for (int db = 0; db < 4; ++db)
#pragma unroll
                for (int s2 = 0; s2 < 2; ++s2) O[db] = __builtin_amdgcn_mfma_f32_32x32x16_bf16(vf[db * 2 + s2], pf[s2], O[db], 0, 0, 0);
        }
        const float lt = l + __shfl_xor(l, 32), inv = 1.f / lt;
        const int s = r + ((32 * jb + qo) << sh), t = b * SEQ + s;
        bf16_t* op = og + ((size_t)g * T + t) * D + head * 128 + 4 * hh;
#pragma unroll
        for (int db = 0; db < 4; ++db)
#pragma unroll
            for (int q4 = 0; q4 < 4; ++q4) {
                const u32x2 w = {pack_bf16(O[db][4 * q4] * inv, O[db][4 * q4 + 1] * inv), pack_bf16(O[db][4 * q4 + 2] * inv, O[db][4 * q4 + 3] * inv)};
                *(u32x2*)(op + 32 * db + 8 * q4) = w;
            }
        if (hh == 0) lse[((size_t)g * T + t) * 16 + head] = m + log2f(lt);
    }
}
__device__ __forceinline__ void p_combine(const bf16_t* __restrict__ og, const float* __restrict__ lse, bf16_t* __restrict__ o) {
    for (size_t i = (size_t)blockIdx.x * NTHR + threadIdx.x; i < (size_t)T * D / 8; i += (size_t)gridDim.x * NTHR) {
        const size_t e = i * 8; const int t = (int)(e >> 11), head = (int)((e & 2047) >> 7);
        const float l0 = lse[((size_t)0 * T + t) * 16 + head], l1 = lse[((size_t)1 * T + t) * 16 + head], l2 = lse[((size_t)2 * T + t) * 16 + head];
        const float mx = fmaxf(l0, fmaxf(l1, l2));
        float w0 = exp2f(l0 - mx), w1 = exp2f(l1 - mx), w2 = exp2f(l2 - mx); const float inv = 1.f / (w0 + w1 + w2); w0 *= inv; w1 *= inv; w2 *= inv;
        const u32x4 a0 = *(const u32x4*)(og + e), a1 = *(const u32x4*)(og + (size_t)T * D + e), a2 = *(const u32x4*)(og + (size_t)2 * T * D + e);
        u32x4 res;
#pragma unroll
        for (int k = 0; k < 4; ++k) {
            const float lo = w0 * __uint_as_float(a0[k] << 16) + w1 * __uint_as_float(a1[k] << 16) + w2 * __uint_as_float(a2[k] << 16);
            const float hi = w0 * __uint_as_float(a0[k] & 0xffff0000u) + w1 * __uint_as_float(a1[k] & 0xffff0000u) + w2 * __uint_as_float(a2[k] & 0xffff0000u);
            res[k] = pack_bf16(lo, hi);
        }
        *(u32x4*)(o + e) = res;
    }
}


constexpr size_t WS_Y = WS_QF;
constexpr size_t WS_ACT = WS_Y + 32 * MB;
constexpr size_t WS_YB = WS_ACT + 24 * MB;
constexpr size_t WS_U = WS_YB + 64 * MB;
constexpr size_t WS_ABT = WS_U + 32 * MB;
constexpr size_t WS_YF = WS_ABT + 64 * MB;
constexpr size_t WS_X1 = WS_FAST_END;
constexpr size_t WS_X2 = WS_X1 + 64 * MB;
constexpr size_t WS_T2 = WS_YF + 32 * MB;
constexpr size_t WS_D12 = WS_X2 + 64 * MB;
constexpr size_t WS_END2 = WS_D12 + 5 * MB;
static_assert(WS_T2 + 64 * MB <= WS_FAST_END, "overlay");
constexpr int LDS_TB = LDS_MISC + 64;

struct EpiBf16 {
    bf16_t* O; int ldc; float scale; int mode;
    __device__ __forceinline__ void operator()(const f32x4 (&acc)[2][2][4][2], const pg8::Unit& u, int wr, int wc, int fr, int fq) const {
        bf16_t* base = O + (mode == 1 ? (size_t)u.e * 1024 * 4096 : (size_t)0);
        const int row0 = u.pm * 256 + wr * 64 + fr, col0 = u.pn * 256 + wc * 32 + 8 * fq;
#pragma unroll
        for (int ai = 0; ai < 2; ++ai)
#pragma unroll
            for (int m = 0; m < 4; ++m) { bf16_t* rowp = base + (size_t)(row0 + ai * 128 + m * 16) * ldc + col0;
#pragma unroll
                for (int bj = 0; bj < 2; ++bj) { const f32x4 v0 = acc[ai][bj][m][0] * scale, v1 = acc[ai][bj][m][1] * scale;
                    *(u32x4*)(rowp + bj * 128) = (u32x4){pack_bf16(v0[0], v0[1]), pack_bf16(v0[2], v0[3]), pack_bf16(v1[0], v1[1]), pack_bf16(v1[2], v1[3])}; } }
    }
};

template <int NY, bool LAST>
__device__ __forceinline__ void row_ln(const int row, const int lane, const float* __restrict__ xin, const bf16_t* __restrict__ y0, const bf16_t* __restrict__ y1, const float* __restrict__ modg,
                                       const float* __restrict__ lnw, const float* __restrict__ lnb, float* __restrict__ xout, const float* __restrict__ modn, bf16_t* __restrict__ hout, f32x4 (&h)[8]) {
    const int b = row >> 12; unsigned lo4 = 4u * (unsigned)lane;
    asm volatile("" : "+v"(lo4));
    const float* xr = xin + (size_t)row * D; const bf16_t* y0r = y0 + (size_t)row * D; const bf16_t* y1r = y1 + (size_t)row * D; const float* gr = modg + b * 6144 + 4096;
    f32x4 z[8]; float sum = 0.f;
#pragma unroll
    for (int i = 0; i < 8; ++i) {
        const f32x4 xv = *(const f32x4*)(xr + 256 * i + lo4); const f32x4 gt = *(const f32x4*)(gr + 256 * i + lo4);
        const u32x2 ya = *(const u32x2*)(y0r + 256 * i + lo4);
        f32x4 yv = {__uint_as_float(ya[0] << 16), __uint_as_float(ya[0] & 0xffff0000u), __uint_as_float(ya[1] << 16), __uint_as_float(ya[1] & 0xffff0000u)};
        if (NY == 2) { const u32x2 yb = *(const u32x2*)(y1r + 256 * i + lo4); yv += (f32x4){__uint_as_float(yb[0] << 16), __uint_as_float(yb[0] & 0xffff0000u), __uint_as_float(yb[1] << 16), __uint_as_float(yb[1] & 0xffff0000u)}; }
        z[i] = ALPHA * xv + gt * yv; sum += (z[i][0] + z[i][1]) + (z[i][2] + z[i][3]); }
#pragma unroll
    for (int o2 = 32; o2 >= 1; o2 >>= 1) sum += __shfl_xor(sum, o2);
    const float mean = sum * (1.f / D); float q = 0.f;
#pragma unroll
    for (int i = 0; i < 8; ++i) { const f32x4 dd = z[i] - mean; q += (dd[0] * dd[0] + dd[1] * dd[1]) + (dd[2] * dd[2] + dd[3] * dd[3]); }
#pragma unroll
    for (int o2 = 32; o2 >= 1; o2 >>= 1) q += __shfl_xor(q, o2);
    const float rstd = 1.0f / sqrtf(q * (1.f / D) + LN_EPS);
    float* xo_r = xout + (size_t)row * D; bf16_t* ho_r = hout + (size_t)row * D; const float* shr = modn + b * 6144; const float* scr = modn + b * 6144 + 2048;
#pragma unroll
    for (int i = 0; i < 8; ++i) {
        const f32x4 xo = (z[i] - mean) * rstd * *(const f32x4*)(lnw + 256 * i + lo4) + *(const f32x4*)(lnb + 256 * i + lo4);
        *(f32x4*)(xo_r + 256 * i + lo4) = xo;
        if (!LAST) { const f32x4 hv = xo * (1.f + *(const f32x4*)(scr + 256 * i + lo4)) + *(const f32x4*)(shr + 256 * i + lo4);
            *(u32x2*)(ho_r + 256 * i + lo4) = (u32x2){pack_bf16(hv[0], hv[1]), pack_bf16(hv[2], hv[3])}; h[i] = hv; }
        if ((i & 3) == 3) __builtin_amdgcn_sched_barrier(0); }
}
#define LDS6(w, addr, o0) asm volatile("ds_read_b128 %0, %6 offset:%7\n\tds_read_b128 %1, %6 offset:%8\n\tds_read_b128 %2, %6 offset:%9\n\tds_read_b128 %3, %6 offset:%10\n\tds_read_b128 %4, %6 offset:%11\n\tds_read_b128 %5, %6 offset:%12\n\ts_waitcnt lgkmcnt(0)" \
    : "=&v"(w[0]), "=&v"(w[1]), "=&v"(w[2]), "=&v"(w[3]), "=&v"(w[4]), "=&v"(w[5]) : "v"(addr), "i"(o0), "i"((o0) + 2048), "i"((o0) + 4096), "i"((o0) + 6144), "i"((o0) + 8192), "i"((o0) + 10240) : "memory")
template <int Q>
__device__ __forceinline__ void router_round(LAS float* wT, const int tid, const int lane, const float* __restrict__ wr1, const float* __restrict__ wr2, const f32x4 (&h0)[8], const f32x4 (&h1)[8], float (&acc0)[36], float (&acc1)[36]) {
    __syncthreads();
#pragma unroll 1
    for (int id = tid; id < 512 * 9; id += NTHR) { const int kl = id / 9, f = id % 9, k = Q * 512 + kl;
        const f32x4 w = f == 0 ? *(const f32x4*)(wr1 + k * 4) : *(const f32x4*)(wr2 + k * 32 + (f - 1) * 4); const int c0 = f == 0 ? 0 : 4 * f;
        wT[(c0 + 0) * 512 + kl] = w[0]; wT[(c0 + 1) * 512 + kl] = w[1]; wT[(c0 + 2) * 512 + kl] = w[2]; wT[(c0 + 3) * 512 + kl] = w[3]; }
    __syncthreads();
    unsigned a0 = (unsigned)(size_t)wT + 16u * (unsigned)lane; asm volatile("" : "+v"(a0)); const unsigned a1 = a0 + 24u * 2048u;
#define RR_GROUP(ha, hb, base, c6, off) do { f32x4 w[6]; LDS6(w, base, off); _Pragma("unroll") for (int c = 0; c < 6; ++c) { \
        acc0[(c6) + c] += (ha[0] * w[c][0] + ha[1] * w[c][1]) + (ha[2] * w[c][2] + ha[3] * w[c][3]); acc1[(c6) + c] += (hb[0] * w[c][0] + hb[1] * w[c][1]) + (hb[2] * w[c][2] + hb[3] * w[c][3]); } \
        asm volatile("" : "+v"(acc0[(c6)]), "+v"(acc0[(c6) + 1]), "+v"(acc0[(c6) + 2]), "+v"(acc0[(c6) + 3]), "+v"(acc0[(c6) + 4]), "+v"(acc0[(c6) + 5]), \
                          "+v"(acc1[(c6)]), "+v"(acc1[(c6) + 1]), "+v"(acc1[(c6) + 2]), "+v"(acc1[(c6) + 3]), "+v"(acc1[(c6) + 4]), "+v"(acc1[(c6) + 5])); } while (0)
    { const f32x4 ha = h0[2 * Q], hb = h1[2 * Q];
      RR_GROUP(ha, hb, a0, 0, 0); RR_GROUP(ha, hb, a0, 6, 12288); RR_GROUP(ha, hb, a0, 12, 24576); RR_GROUP(ha, hb, a0, 18, 36864); RR_GROUP(ha, hb, a1, 24, 0); RR_GROUP(ha, hb, a1, 30, 12288); }
    { const f32x4 ha = h0[2 * Q + 1], hb = h1[2 * Q + 1];
      RR_GROUP(ha, hb, a0, 0, 1024); RR_GROUP(ha, hb, a0, 6, 13312); RR_GROUP(ha, hb, a0, 12, 25600); RR_GROUP(ha, hb, a0, 18, 37888); RR_GROUP(ha, hb, a1, 24, 1024); RR_GROUP(ha, hb, a1, 30, 13312); }
#undef RR_GROUP
}
template <int NLO, int NHI, int BIT>
__device__ __forceinline__ void rs_level(const float (&r)[NLO + NHI], float (&o)[NLO], const int lane) {
    const bool hi = (lane >> BIT) & 1;
#pragma unroll
    for (int c = 0; c < NLO; ++c) { const float lov = r[c], hiv = c < NHI ? r[c + NLO] : 0.f; const float send = hi ? lov : hiv; o[c] = (hi ? hiv : lov) + __shfl_xor(send, 1 << BIT); }
}
__device__ __forceinline__ void route_row(const float (&acc)[36], const int lrow, const int row, const int lane, LAS float* lg, const float* __restrict__ br1, const float* __restrict__ br2, float* __restrict__ gw, LAS int* hist, LAS int* asgE, LAS int* asgP) {
    float r18[18], r9[9], r5[5], r3[3], r2[2], r1[1];
    rs_level<18, 18, 5>(acc, r18, lane); rs_level<9, 9, 4>(r18, r9, lane); rs_level<5, 4, 3>(r9, r5, lane); rs_level<3, 2, 2>(r5, r3, lane); rs_level<2, 1, 1>(r3, r2, lane); rs_level<1, 1, 0>(r2, r1, lane);
    const int idx3 = ((lane >> 1) & 1) * 2 + (lane & 1), idx5 = ((lane >> 2) & 1) * 3 + idx3;
    const bool valid = (idx3 <= 2) && (idx5 <= (((lane >> 3) & 1) ? 3 : 4));
    const int col = ((lane >> 5) & 1) * 18 + ((lane >> 4) & 1) * 9 + ((lane >> 3) & 1) * 5 + idx5;
    if (valid) lg[col] = r1[0];
    asm volatile("s_waitcnt lgkmcnt(0)" ::: "memory");
    float lc[4]; float mx = -1e30f; int gi = 0;
#pragma unroll
    for (int j = 0; j < 4; ++j) { lc[j] = lg[j] + br1[j]; const bool gt = lc[j] > mx; mx = gt ? lc[j] : mx; gi = gt ? j : gi; }
    float den = 0.f;
#pragma unroll
    for (int j = 0; j < 4; ++j) den += expf(lc[j] - mx);
    const float pg = 1.f / den;
    float v1 = -1e30f, v2 = -1e30f; int i1 = 0, i2 = 0;
#pragma unroll
    for (int j = 0; j < 8; ++j) { const float v = lg[4 + gi * 8 + j] + br2[gi * 8 + j];
        const bool b1 = v > v1, b2 = v > v2;
        v2 = b1 ? v1 : (b2 ? v : v2); i2 = b1 ? i1 : (b2 ? j : i2); v1 = b1 ? v : v1; i1 = b1 ? j : i1; }
    const float e2 = expf(v2 - v1), g1 = pg / (1.f + e2), g2 = pg * e2 / (1.f + e2);
    if (lane == 0) { const int ea = gi * 8 + i1, eb = gi * 8 + i2;
        gw[row * 2] = g1; gw[row * 2 + 1] = g2;
        asgE[lrow * 2] = ea; asgP[lrow * 2] = __hip_atomic_fetch_add(&hist[ea], 1, __ATOMIC_RELAXED, __HIP_MEMORY_SCOPE_WORKGROUP);
        asgE[lrow * 2 + 1] = eb; asgP[lrow * 2 + 1] = __hip_atomic_fetch_add(&hist[eb], 1, __ATOMIC_RELAXED, __HIP_MEMORY_SCOPE_WORKGROUP); }
}
template <int NY, bool ROUTER, bool LAST>
__device__ __forceinline__ void p_rows(LAS unsigned char* lds, const float* __restrict__ xin, const bf16_t* __restrict__ y0, const bf16_t* __restrict__ y1, const float* __restrict__ modg,
                                       const float* __restrict__ lnw, const float* __restrict__ lnb, float* __restrict__ xout, const float* __restrict__ modn, bf16_t* __restrict__ hout,
                                       const float* __restrict__ wr1, const float* __restrict__ br1, const float* __restrict__ wr2, const float* __restrict__ br2,
                                       float* __restrict__ gw, int* __restrict__ list, unsigned* __restrict__ cnt) {
    const int tid = threadIdx.x, lane = tid & 63, wave = __builtin_amdgcn_readfirstlane(tid >> 6);
    LAS float* wT = (LAS float*)lds;
    LAS int* hist = (LAS int*)(lds + 73728);
    LAS float* lgs = (LAS float*)(lds + 73728 + 1024);
    LAS int* basee = hist + 32;
    LAS int* asgE = hist + 64;
    LAS int* asgP = hist + 128;
    for (int rb = blockIdx.x; rb < 256; rb += gridDim.x) {
        if (ROUTER) { if (tid < 32) hist[tid] = 0; __syncthreads(); }
#pragma unroll 1
        for (int p = 0; p < 2; ++p) {
            const int lrow = wave * 4 + p * 2, row = rb * 32 + lrow;
            f32x4 h0[8], h1[8];
            row_ln<NY, LAST>(row, lane, xin, y0, y1, modg, lnw, lnb, xout, modn, hout, h0);
            row_ln<NY, LAST>(row + 1, lane, xin, y0, y1, modg, lnw, lnb, xout, modn, hout, h1);
            if (ROUTER) {
                float acc0[36], acc1[36];
#pragma unroll
                for (int c = 0; c < 36; ++c) { acc0[c] = 0.f; acc1[c] = 0.f; }
                router_round<0>(wT, tid, lane, wr1, wr2, h0, h1, acc0, acc1);
                router_round<1>(wT, tid, lane, wr1, wr2, h0, h1, acc0, acc1);
                router_round<2>(wT, tid, lane, wr1, wr2, h0, h1, acc0, acc1);
                router_round<3>(wT, tid, lane, wr1, wr2, h0, h1, acc0, acc1);
                route_row(acc0, lrow, row, lane, lgs + lrow * 40, br1, br2, gw, hist, asgE, asgP);
                route_row(acc1, lrow + 1, row + 1, lane, lgs + (lrow + 1) * 40, br1, br2, gw, hist, asgE, asgP);
            }
        }
        if (ROUTER) {
            __syncthreads();
            if (tid < 32) { const int n = hist[tid]; basee[tid] = n ? (int)__hip_atomic_fetch_add(cnt + tid, (unsigned)n, __ATOMIC_RELAXED, __HIP_MEMORY_SCOPE_AGENT) : 0; }
            __syncthreads();
            if (tid < 64) { const int e = asgE[tid]; list[e * 8192 + basee[e] + asgP[tid]] = (rb * 32 + (tid >> 1)) * 2 + (tid & 1); }
            __syncthreads();
        }
    }
}

__device__ __forceinline__ void moe_setup(LAS unsigned char* lds, const unsigned* cnt) {
    LAS int* tb = (LAS int*)(lds + LDS_TB);
    if (threadIdx.x == 0) { int s = 0; for (int e = 0; e < 32; ++e) { const int c = (int)__hip_atomic_load(cnt + e, __ATOMIC_RELAXED, __HIP_MEMORY_SCOPE_AGENT); tb[e] = s; tb[33 + e] = c; s += (c + 255) >> 8; } tb[32] = s; }
    __syncthreads();
}
struct MoeSched {
    static constexpr bool A_INV = false, B_INV = true;
    LAS const int* tb; const bf16_t* A; const bf16_t* Bt; const int* list; int K, ldb, NT, ntshift, nrowsB, G, c; bool gather, perm;
    __device__ bool next(int i, pg8::Unit& u) const {
        const int L = i * G + c, tm = L >> ntshift; if (tm >= tb[32]) return false;
        int e = 0;
#pragma unroll 1
        for (int k = 1; k < 32; ++k) e = (tb[k] <= tm) ? k : e;
        u.pm = tm; u.pn = L & (NT - 1); u.e = e; u.row0 = (tm - tb[e]) << 8; return true;
    }
    __device__ __forceinline__ const char* a_base(const pg8::Unit& u) const { return gather ? (const char*)A : (const char*)A + (size_t)u.pm * 256 * K * 2; }
    __device__ __forceinline__ const char* b_base(const pg8::Unit& u) const { return (const char*)Bt + ((size_t)u.e * nrowsB + (size_t)u.pn * 256) * K * 2; }
    __device__ __forceinline__ void a_offs(const pg8::Unit& u, const int (&R)[2], const int (&C)[2], unsigned (&o)[2][2]) const {
        const int cn = tb[33 + u.e];
#pragma unroll
        for (int h = 0; h < 2; ++h)
#pragma unroll
            for (int i = 0; i < 2; ++i) {
                if (gather) { const int row = u.row0 + h * 128 + R[i]; const int tok = row < cn ? (list[u.e * 8192 + row] >> 1) : 0; o[h][i] = (unsigned)(tok * K + C[i]) * 2u; }
                else o[h][i] = (unsigned)((h * 128 + R[i]) * K + C[i]) * 2u;
            }
    }
    __device__ __forceinline__ void b_offs(const pg8::Unit&, const int (&R)[2], const int (&C)[2], unsigned (&o)[2][2]) const {
#pragma unroll
        for (int h = 0; h < 2; ++h)
#pragma unroll
            for (int i = 0; i < 2; ++i) { const int Rb = perm ? ((R[i] & ~31) + pg8::perm32(R[i] & 31)) : R[i]; o[h][i] = (unsigned)((h * 128 + Rb) * K + C[i]) * 2u; }
    }
    __device__ __forceinline__ unsigned kstepA() const { return 128u; }
    __device__ __forceinline__ unsigned kstepB() const { return 128u; }
};
struct EpiAct {
    bf16_t* act;
    __device__ __forceinline__ void operator()(const f32x4 (&acc)[2][2][4][2], const pg8::Unit& u, int wr, int wc, int fr, int fq) const {
#pragma unroll
        for (int ai = 0; ai < 2; ++ai)
#pragma unroll
            for (int m = 0; m < 4; ++m) { const int arow = u.pm * 256 + ai * 128 + wr * 64 + m * 16 + fr;
#pragma unroll
                for (int bj = 0; bj < 2; ++bj) { const int j0 = (8 * u.pn + 4 * bj + wc) * 16 + 4 * fq; const f32x4 g = acc[ai][bj][m][0], up = acc[ai][bj][m][1]; f32x4 a;
#pragma unroll
                    for (int e = 0; e < 4; ++e) a[e] = g[e] / (1.f + __expf(-g[e])) * up[e];
                    *(u32x2*)(act + (size_t)arow * 512 + j0) = (u32x2){pack_bf16(a[0], a[1]), pack_bf16(a[2], a[3])}; } }
    }
};
struct EpiDown {
    LAS const int* tb; const int* list; const float* gw; bf16_t* yb;
    __device__ __forceinline__ void operator()(const f32x4 (&acc)[2][2][4][2], const pg8::Unit& u, int wr, int wc, int fr, int fq) const {
        const int cn = tb[33 + u.e], col0 = u.pn * 256 + wc * 32 + 8 * fq;
#pragma unroll
        for (int ai = 0; ai < 2; ++ai)
#pragma unroll
            for (int m = 0; m < 4; ++m) { const int row = u.row0 + ai * 128 + wr * 64 + m * 16 + fr;
                if (row < cn) { const int a = list[u.e * 8192 + row]; const float w = gw[a]; bf16_t* rowp = yb + (size_t)(a & 1) * T * D + (size_t)(a >> 1) * D + col0;
#pragma unroll
                    for (int bj = 0; bj < 2; ++bj) { const f32x4 v0 = acc[ai][bj][m][0] * w, v1 = acc[ai][bj][m][1] * w;
                        *(u32x4*)(rowp + bj * 128) = (u32x4){pack_bf16(v0[0], v0[1]), pack_bf16(v0[2], v0[3]), pack_bf16(v1[0], v1[1]), pack_bf16(v1[2], v1[3])}; } } }
    }
};

__device__ __forceinline__ void p0_dft(LAS unsigned char* lds, bf16_t* Dc, bf16_t* D12) {
    LAS float* tab = (LAS float*)lds;
    __syncthreads();
    for (int i = threadIdx.x; i < 4096; i += NTHR) { float s, c; sincospif((float)i / 2048.0f, &s, &c); tab[i] = c; }
    __syncthreads();
    for (size_t i = (size_t)blockIdx.x * NTHR + threadIdx.x; i < (size_t)1024 * 512 / 8; i += (size_t)gridDim.x * NTHR) {
        const size_t e = i * 8; const int m = (int)(e >> 9), c0 = (int)(e & 511), cp = m >> 1, part = m & 1; unsigned w[4];
#pragma unroll
        for (int j = 0; j < 8; j += 2) { const int i0 = (((c0 + j) * cp) & 511) * 8, i1 = (((c0 + j + 1) * cp) & 511) * 8;
            const float a = part ? tab[(i0 - 1024) & 4095] : tab[i0], b = part ? tab[(i1 - 1024) & 4095] : tab[i1]; w[j >> 1] = pack_bf16(a, b); }
        *(u32x4*)(Dc + e) = (u32x4){w[0], w[1], w[2], w[3]};
    }
    for (size_t i = (size_t)blockIdx.x * NTHR + threadIdx.x; i < (size_t)65 * 256 * 128; i += (size_t)gridDim.x * NTHR) {
        const int blk = (int)(i >> 15), r = (int)(i >> 7) & 255, k = (int)i & 127, half = k >> 6, kk = k & 63; float v = 0.f;
        if (blk == 0) { if (r < 128) { const int idx = ((r & 63) * kk * 64) & 4095; const float cs = tab[idx], sn = tab[(idx - 1024) & 4095]; v = r < 64 ? (half ? -sn : cs) : (half ? -cs : -sn); } }
        else if (r < 64) { const int idx = (kk * (64 * r + (blk - 1))) & 4095; v = half ? tab[(idx - 1024) & 4095] : tab[idx]; }
        D12[i] = (bf16_t)(pack_bf16(v, v) & 0xffffu);
    }
    __syncthreads();
}
struct ChanSched {
    static constexpr bool A_INV = true, B_INV = false;
    const bf16_t* Dc; const bf16_t* u; int G, c;
    __device__ bool next(int i, pg8::Unit& un) const { const int L = i * G + c; if (L >= 512) return false; un.e = L >> 6; const int rem = L & 63; un.pm = rem & 3; un.pn = rem >> 2; un.row0 = 0; return true; }
    __device__ __forceinline__ const char* a_base(const pg8::Unit& un) const { return (const char*)Dc + (size_t)un.pm * 256 * 512 * 2; }
    __device__ __forceinline__ const char* b_base(const pg8::Unit& un) const { return (const char*)u + ((size_t)(un.e >> 2) * 4096 * 2048 + (un.e & 3) * 512) * 2; }
    __device__ __forceinline__ void a_offs(const pg8::Unit&, const int (&R)[2], const int (&C)[2], unsigned (&o)[2][2]) const {
#pragma unroll
        for (int h = 0; h < 2; ++h)
#pragma unroll
            for (int i = 0; i < 2; ++i) o[h][i] = (unsigned)((h * 128 + R[i]) * 512 + C[i]) * 2u; }
    __device__ __forceinline__ void b_offs(const pg8::Unit& un, const int (&R)[2], const int (&C)[2], unsigned (&o)[2][2]) const {
#pragma unroll
        for (int h = 0; h < 2; ++h)
#pragma unroll
            for (int i = 0; i < 2; ++i) { const int n = un.pn * 256 + h * 128 + (R[i] & ~31) + pg8::perm32(R[i] & 31), s = (n >> 6) + 64 * (n & 63); o[h][i] = (unsigned)(s * 2048 + C[i]) * 2u; } }
    __device__ __forceinline__ unsigned kstepA() const { return 128u; }
    __device__ __forceinline__ unsigned kstepB() const { return 128u; }
};
struct Fft1Sched {
    static constexpr bool A_INV = true, B_INV = false;
    const bf16_t* D1; const bf16_t* ABt; int G, c;
    __device__ bool next(int i, pg8::Unit& un) const { const int L = i * G + c; if (L >= 1024) return false; un.pm = 0; un.pn = L; un.e = 0; un.row0 = 0; return true; }
    __device__ __forceinline__ const char* a_base(const pg8::Unit&) const { return (const char*)D1; }
    __device__ __forceinline__ const char* b_base(const pg8::Unit&) const { return (const char*)ABt; }
    __device__ __forceinline__ void a_offs(const pg8::Unit&, const int (&R)[2], const int (&C)[2], unsigned (&o)[2][2]) const {
#pragma unroll
        for (int h = 0; h < 2; ++h)
#pragma unroll
            for (int i = 0; i < 2; ++i) o[h][i] = (unsigned)((h * 128 + R[i]) * 128 + C[i]) * 2u; }
    __device__ __forceinline__ void b_offs(const pg8::Unit& un, const int (&R)[2], const int (&C)[2], unsigned (&o)[2][2]) const {
#pragma unroll
        for (int h = 0; h < 2; ++h)
#pragma unroll
            for (int i = 0; i < 2; ++i) { int rr = R[i], cc = C[i]; asm volatile("" : "+v"(rr), "+v"(cc));
                const int n = un.pn * 256 + h * 128 + (rr & ~31) + pg8::perm32(rr & 31); o[h][i] = (unsigned)((n >> 6) * 8192 + (n & 63) * 64 + cc) * 2u; } }
    __device__ __forceinline__ unsigned kstepA() const { return 128u; }
    __device__ __forceinline__ unsigned kstepB() const { return 8192u; }
};
struct EpiFft1 {
    bf16_t* T2;
    __device__ __forceinline__ void operator()(const f32x4 (&acc)[2][2][4][2], const pg8::Unit& u, int wr, int wc, int fr, int fq) const {
#pragma unroll
        for (int m = 0; m < 4; ++m) { const int k2 = 16 * m + fr;
#pragma unroll
            for (int bj = 0; bj < 2; ++bj) { const int n0 = u.pn * 256 + bj * 128 + wc * 32 + 8 * fq, colg = n0 >> 6, s10 = n0 & 63;
                const f32x4 v0 = acc[0][bj][m][0], v1 = acc[0][bj][m][1];
                *(u32x4*)(T2 + ((size_t)(colg * 64 + k2) * 2 + wr) * 64 + s10) = (u32x4){pack_bf16(v0[0], v0[1]), pack_bf16(v0[2], v0[3]), pack_bf16(v1[0], v1[1]), pack_bf16(v1[2], v1[3])}; } }
    }
};
struct Fft2Sched {
    static constexpr bool A_INV = true, B_INV = false;
    const bf16_t* D2; const bf16_t* T2; int G, c;
    __device__ bool next(int i, pg8::Unit& un) const { const int L = i * G + c; if (L >= 1024) return false; un.pm = 0; un.pn = L; un.e = 0; un.row0 = 0; return true; }
    __device__ __forceinline__ const char* a_base(const pg8::Unit& un) const { return (const char*)D2 + (size_t)((un.pn >> 3) & 63) * 256 * 128 * 2; }
    __device__ __forceinline__ const char* b_base(const pg8::Unit&) const { return (const char*)T2; }
    __device__ __forceinline__ void a_offs(const pg8::Unit&, const int (&R)[2], const int (&C)[2], unsigned (&o)[2][2]) const {
#pragma unroll
        for (int h = 0; h < 2; ++h)
#pragma unroll
            for (int i = 0; i < 2; ++i) o[h][i] = (unsigned)((h * 128 + R[i]) * 128 + C[i]) * 2u; }
    __device__ __forceinline__ void b_offs(const pg8::Unit& un, const int (&R)[2], const int (&C)[2], unsigned (&o)[2][2]) const {
#pragma unroll
        for (int h = 0; h < 2; ++h)
#pragma unroll
            for (int i = 0; i < 2; ++i) { const int n = un.pn * 256 + h * 128 + (R[i] & ~31) + pg8::perm32(R[i] & 31), b = n >> 17, k2 = (n >> 11) & 63, col = n & 2047;
                o[h][i] = (unsigned)(((b * 2048 + col) * 64 + k2) * 128 + C[i]) * 2u; } }
    __device__ __forceinline__ unsigned kstepA() const { return 128u; }
    __device__ __forceinline__ unsigned kstepB() const { return 128u; }
};
struct EpiFft2 {
    bf16_t* Y; float scale;
    __device__ __forceinline__ void operator()(const f32x4 (&acc)[2][2][4][2], const pg8::Unit& u, int wr, int wc, int fr, int fq) const {
        if (wr != 0) return;
#pragma unroll
        for (int m = 0; m < 4; ++m) { const int k1 = 16 * m + fr;
#pragma unroll
            for (int bj = 0; bj < 2; ++bj) { const int n0 = u.pn * 256 + bj * 128 + wc * 32 + 8 * fq, b = n0 >> 17, k2 = (n0 >> 11) & 63, col = n0 & 2047;
                const f32x4 v0 = acc[0][bj][m][0] * scale, v1 = acc[0][bj][m][1] * scale;
                *(u32x4*)(Y + (size_t)(b * 4096 + 64 * k1 + k2) * 2048 + col) = (u32x4){pack_bf16(v0[0], v0[1]), pack_bf16(v0[2], v0[3]), pack_bf16(v1[0], v1[1]), pack_bf16(v1[2], v1[3])}; } }
    }
};

constexpr int NPHASE = 19;
#ifndef REP_MASK
#define REP_MASK 0
#endif
#define PH_BEGIN(k) _Pragma("unroll") for (int rp = 0; rp < 1 + ((REP_MASK >> (k)) & 1); ++rp) { if (rp) xcd_barrier(bar);
__global__ void __launch_bounds__(NTHR, 2) mk_fwd(Args a) {
    extern __shared__ __attribute__((aligned(16))) unsigned char lds_raw[];
    LAS unsigned char* lds = (LAS unsigned char*)lds_raw;
    unsigned char* ws = a.ws;
    volatile LAS unsigned* misc = (volatile LAS unsigned*)(lds + LDS_MISC);
    if (threadIdx.x < 4) misc[threadIdx.x] = 0u;
    __syncthreads();
    const int lo = a.ph_lo, hi = a.ph_hi;
    XcdBarrier bar; bar.bar = (unsigned*)(ws + WS_CTL) + CW_BAR; bar.x = 0; bar.st = misc;
    if (hi - lo > 1) bar = xcd_barrier_post((unsigned*)(ws + WS_CTL) + CW_BAR, misc);
#define IN(k) (lo <= (k) && (k) < hi)
#define SEAM(k) do { if (IN(k) && IN((k) + 1)) xcd_barrier(bar); } while (0)
    float* mod = (float*)(ws + WS_MOD); float* rot = (float*)(ws + WS_ROT);
    bf16_t* hbuf = (bf16_t*)(ws + WS_H); bf16_t* ybr = (bf16_t*)(ws + WS_Y); bf16_t* yb = (bf16_t*)(ws + WS_YB); bf16_t* act = (bf16_t*)(ws + WS_ACT);
    float* x1 = (float*)(ws + WS_X1); float* x2 = (float*)(ws + WS_X2); float* gw = (float*)(ws + WS_GW); int* list = (int*)(ws + WS_LIST);
    unsigned* cnt = (unsigned*)(ws + WS_CTL) + CW_CNT;
    LAS const int* tb = (LAS const int*)(lds + LDS_TB);
    const float* x = a.in[0]; const float* ln_g = a.in[9]; const float* ln_b = a.in[10];
    const int G = gridDim.x, cid = blockIdx.x;

    if (IN(0)) { PH_BEGIN(0)  p0_adaln(a, lds, mod); p0_tables(a, rot); p0_dft(lds, (bf16_t*)(ws + WS_DC), (bf16_t*)(ws + WS_D12)); p0_transposes(a, lds);  } }
    SEAM(0);
    if (IN(1)) { PH_BEGIN(1)  p_modulate(x, mod, hbuf);  } }
    SEAM(1);
    if (IN(2)) { PH_BEGIN(2)  QkvSched S{ws, G, cid};
        EpiQKV E{(bf16_t*)(ws + WS_QF), (bf16_t*)(ws + WS_KF), (bf16_t*)(ws + WS_VF), rot};
        pg8::gemm_phase<EpiQKV, QkvSched>(lds, D, S, E); } }
    SEAM(2);
    if (IN(3)) { PH_BEGIN(3)  p_attention((const bf16_t*)(ws + WS_QF), (const bf16_t*)(ws + WS_KF), (const bf16_t*)(ws + WS_VF), (bf16_t*)(ws + WS_OG), (float*)(ws + WS_LSE));  } }
    SEAM(3);
    if (IN(4)) { PH_BEGIN(4)  p_combine((const bf16_t*)(ws + WS_OG), (const float*)(ws + WS_LSE), (bf16_t*)(ws + WS_O));  } }
    SEAM(4);
    if (IN(5)) { PH_BEGIN(5)  pg8::PlainSched S; S.init((const bf16_t*)(ws + WS_O), (const bf16_t*)(ws + WS_WO), T, D, D, G, cid); EpiBf16 E{ybr, D, 1.f, 0};
        pg8::gemm_phase<EpiBf16, pg8::PlainSched>(lds, D, S, E);  } }
    SEAM(5);
    if (IN(6)) { PH_BEGIN(6)  p_rows<1, true, false>(lds, x, ybr, ybr, mod, ln_g, ln_b, x1, mod + 1 * 12288, hbuf, a.in[11], a.in[12], a.in[13], a.in[14], gw, list, cnt);  } }
    SEAM(6);
    if (IN(7)) { PH_BEGIN(7)  moe_setup(lds, cnt);
        MoeSched S{tb, hbuf, (const bf16_t*)(ws + WS_WGU), list, D, D, 4, 2, 1024, G, cid, true, false}; EpiAct E{act};
        pg8::gemm_phase<EpiAct, MoeSched>(lds, D, S, E);  } }
    SEAM(7);
    if (IN(8)) { PH_BEGIN(8)  moe_setup(lds, cnt);
        MoeSched S{tb, act, (const bf16_t*)(ws + WS_WD), list, ED, ED, 8, 3, 2048, G, cid, false, true}; EpiDown E{tb, list, gw, yb};
        pg8::gemm_phase<EpiDown, MoeSched>(lds, ED, S, E);  } }
    SEAM(8);
    if (IN(9)) { PH_BEGIN(9)  p_rows<2, false, false>(lds, x1, yb, yb + (size_t)T * D, mod + 1 * 12288, ln_g + D, ln_b + D, x2, mod + 2 * 12288, hbuf, nullptr, nullptr, nullptr, nullptr, nullptr, nullptr, nullptr);  } }
    SEAM(9);
    if (IN(10)) { PH_BEGIN(10)  pg8::PlainSched S; S.init(hbuf, (const bf16_t*)(ws + WS_WIN), T, D, D, G, cid); EpiBf16 E{(bf16_t*)(ws + WS_U), D, 1.f, 0};
        pg8::gemm_phase<EpiBf16, pg8::PlainSched>(lds, D, S, E);  } }
    SEAM(10);
    if (IN(11)) { PH_BEGIN(11)  ChanSched S{(const bf16_t*)(ws + WS_DC), (const bf16_t*)(ws + WS_U), G, cid}; EpiBf16 E{(bf16_t*)(ws + WS_ABT), 4096, 1.f, 1};
        pg8::gemm_phase<EpiBf16, ChanSched>(lds, 512, S, E);  } }
    SEAM(11);
    if (IN(12)) { PH_BEGIN(12)  Fft1Sched S{(const bf16_t*)(ws + WS_D12), (const bf16_t*)(ws + WS_ABT), G, cid}; EpiFft1 E{(bf16_t*)(ws + WS_T2)};
        pg8::gemm_phase<EpiFft1, Fft1Sched, true>(lds, 128, S, E); } }
    SEAM(12);
    if (IN(13)) { PH_BEGIN(13)  Fft2Sched S{(const bf16_t*)(ws + WS_D12) + 256 * 128, (const bf16_t*)(ws + WS_T2), G, cid}; EpiFft2 E{(bf16_t*)(ws + WS_YF), 6.9053396600248786e-4f};
        pg8::gemm_phase<EpiFft2, Fft2Sched, true>(lds, 128, S, E); } }
    SEAM(13);
    if (IN(14)) { PH_BEGIN(14)  pg8::PlainSched S; S.init((const bf16_t*)(ws + WS_YF), (const bf16_t*)(ws + WS_WOUT), T, D, D, G, cid); EpiBf16 E{ybr, D, 1.f, 0};
        pg8::gemm_phase<EpiBf16, pg8::PlainSched>(lds, D, S, E);  } }
    SEAM(14);
    if (IN(15)) { PH_BEGIN(15)  p_rows<1, true, false>(lds, x2, ybr, ybr, mod + 2 * 12288, ln_g + 2 * D, ln_b + 2 * D, x1, mod + 3 * 12288, hbuf, a.in[11] + D * 4, a.in[12] + 4, a.in[13] + D * 32, a.in[14] + 32, gw, list, cnt + 32);  } }
    SEAM(15);
    if (IN(16)) { PH_BEGIN(16)  moe_setup(lds, cnt + 32);
        MoeSched S{tb, hbuf, (const bf16_t*)(ws + WS_WGU) + (size_t)32 * 1024 * 2048, list, D, D, 4, 2, 1024, G, cid, true, false}; EpiAct E{act};
        pg8::gemm_phase<EpiAct, MoeSched>(lds, D, S, E);  } }
    SEAM(16);
    if (IN(17)) { PH_BEGIN(17)  moe_setup(lds, cnt + 32);
        MoeSched S{tb, act, (const bf16_t*)(ws + WS_WD) + (size_t)32 * 2048 * 512, list, ED, ED, 8, 3, 2048, G, cid, false, true}; EpiDown E{tb, list, gw, yb};
        pg8::gemm_phase<EpiDown, MoeSched>(lds, ED, S, E);  } }
    SEAM(17);
    if (IN(18)) { PH_BEGIN(18) p_rows<2, false, true>(lds, x1, yb, yb + (size_t)T * D, mod + 3 * 12288, ln_g + 3 * D, ln_b + 3 * D, a.out, nullptr, nullptr, nullptr, nullptr, nullptr, nullptr, nullptr, nullptr, nullptr); } }
#undef IN
#undef SEAM
}

}

extern "C" void kernel_launch(void* const* d_in, const int* in_sizes, int n_in, void* d_out, int out_size, void* d_ws, size_t ws_size, hipStream_t stream) {
    (void)in_sizes; (void)n_in; (void)out_size; (void)ws_size;
    static bool attr = false;
    if (!attr) { (void)hipFuncSetAttribute((const void*)mk_fwd, hipFuncAttributeMaxDynamicSharedMemorySize, LDS_BYTES); attr = true; }
    (void)hipMemsetAsync((char*)d_ws + WS_CTL, 0, CTL_BYTES, stream);
    Args a{};
    for (int i = 0; i < 18; ++i) a.in[i] = (const float*)d_in[i];
    a.out = (float*)d_out; a.ws = (unsigned char*)d_ws;
    a.ph_lo = 0; a.ph_hi = NPHASE; a.rep = 0;
    hipLaunchKernelGGL(mk_fwd, dim3(256), dim3(NTHR), LDS_BYTES, stream, a);
}
```

```cpp
#include <hip/hip_runtime.h>
#include <stdint.h>

namespace {
constexpr int D = 2048, NB = 2, SEQ = 4096, T = NB * SEQ, NQKV = 18432, NE = 32, ED = 512;
constexpr float ALPHA = 1.41421356237309515f;
constexpr float LN_EPS = 1e-5f;

#define LAS __attribute__((address_space(3)))
typedef unsigned short bf16_t;
typedef short bf16x8 __attribute__((ext_vector_type(8)));
typedef float f32x4 __attribute__((ext_vector_type(4)));
typedef float f32x16 __attribute__((ext_vector_type(16)));
typedef unsigned u32x4 __attribute__((ext_vector_type(4)));
typedef unsigned u32x2 __attribute__((ext_vector_type(2)));

constexpr float QSCALE = 0.08838834764831845f * 1.4426950408889634f;
constexpr int NTHR = 512;
constexpr int LDS_BYTES = 147456;
constexpr int LDS_MISC = 143360;

constexpr size_t MB = 1024 * 1024;
constexpr size_t WS_CTL = 0;
constexpr size_t CTL_BYTES = 32768;
constexpr size_t WS_MOD = WS_CTL + CTL_BYTES;
constexpr size_t WS_ROT = WS_MOD + 196608;
constexpr size_t WS_LSE = WS_ROT + 1 * MB;
constexpr size_t WS_EID = WS_LSE + 1536 * 1024;
constexpr size_t WS_GW = WS_EID + 65536;
constexpr size_t WS_LIST = WS_GW + 65536;
constexpr size_t WS_DC = WS_LIST + 1 * MB;
constexpr size_t WS_WQKV = WS_DC + 1 * MB;
constexpr size_t WS_WO = WS_WQKV + (size_t)18432 * 2048 * 2;
constexpr size_t WS_WIN = WS_WO + 8 * MB;
constexpr size_t WS_WOUT = WS_WIN + 8 * MB;
constexpr size_t WS_WGU = WS_WOUT + 8 * MB;
constexpr size_t WS_WD = WS_WGU + 256 * MB;
constexpr size_t WS_H = WS_WD + 128 * MB;
constexpr size_t WS_O = WS_H + 32 * MB;
constexpr size_t WS_QF = WS_O + 32 * MB;
constexpr size_t WS_KF = WS_QF + 96 * MB;
constexpr size_t WS_VF = WS_KF + 96 * MB;
constexpr size_t WS_OG = WS_VF + 96 * MB;
constexpr size_t WS_FAST_END = WS_OG + 96 * MB;

constexpr int CW_BAR = 0;
constexpr int CW_CNT = 4096;

__device__ __forceinline__ unsigned pack_bf16(float lo, float hi) { unsigned r; asm("v_cvt_pk_bf16_f32 %0, %1, %2" : "=v"(r) : "v"(lo), "v"(hi)); return r; }
__device__ __forceinline__ float bf16_to_f32(bf16_t v) { return __uint_as_float(((unsigned)v) << 16); }
__device__ __forceinline__ int pi32(int x) { return (x & ~12) | ((x & 4) << 1) | ((x & 8) >> 1); }

__device__ __forceinline__ size_t tile_block(int g, int b, int head, int s, int& jo) {
    const int sh = g * 2;
    const int r = s & ((1 << sh) - 1), j = s >> sh, nbr = 128 >> sh;
    jo = j & 31;
    return (size_t)(((g * 2 + b) * 16 + head) * 128 + r * nbr + (j >> 5));
}
__device__ __forceinline__ size_t q_index(int g, int b, int head, int s, int d) { int jo; const size_t blk = tile_block(g, b, head, s, jo); const int c = d >> 3; return ((blk * 8 + (c >> 1)) * 64 + (c & 1) * 32 + jo) * 8 + (d & 7); }
__device__ __forceinline__ size_t k_index(int g, int b, int head, int s, int d) { int jo; const size_t blk = tile_block(g, b, head, s, jo); const int c = d >> 3; return ((blk * 8 + (c >> 1)) * 64 + (c & 1) * 32 + pi32(jo)) * 8 + (d & 7); }
__device__ __forceinline__ size_t v_index(int g, int b, int head, int s, int d) { int jo; const size_t blk = tile_block(g, b, head, s, jo); return ((blk * 8 + (d >> 5) * 2 + (jo >> 4)) * 64 + ((jo >> 3) & 1) * 32 + (d & 31)) * 8 + (jo & 7); }

#define XB_TMO      128
#define XB_XCNT(j)  (256  + 64 * (j))
#define XB_XSUB(j)  (1280 + 64 * (j))
#define XB_XGEN(j)  (2304 + 64 * (j))
#define XB_TOP      3328
#define XB_TOPGEN   3392
#define XCD_BAR_WORDS 3456
#define XB_SPIN_CAP (1u << 18)
__device__ __forceinline__ unsigned xb_ld(unsigned* p)              { return __hip_atomic_load(p, __ATOMIC_RELAXED, __HIP_MEMORY_SCOPE_AGENT); }
__device__ __forceinline__ unsigned xb_add(unsigned* p, unsigned v) { return __hip_atomic_fetch_add(p, v, __ATOMIC_RELAXED, __HIP_MEMORY_SCOPE_AGENT); }
__device__ __forceinline__ unsigned xb_xcc_id() { return (unsigned)__builtin_amdgcn_s_getreg((3 << 11) | 20) & 0xFu; }
#define XB_SPIN(cond, bar) do { unsigned _sp = 0; while (cond) { __builtin_amdgcn_s_sleep(1); \
    if ((++_sp & 255u) == 0u) { if (xb_ld(&(bar)[XB_TMO])) break; if (_sp > XB_SPIN_CAP) { atomicAdd(&(bar)[XB_TMO], 1u); break; } } } } while (0)
struct XcdBarrier { unsigned* bar; unsigned x; volatile LAS unsigned* st; };
__device__ __forceinline__ XcdBarrier xcd_barrier_post(unsigned* bar, volatile LAS unsigned* st) {
    XcdBarrier b; b.bar = bar; b.x = xb_xcc_id(); b.st = st;
    if (threadIdx.x == 0) (void)xb_add(&bar[XB_XCNT(b.x)], 1u);
    return b;
}
__device__ __forceinline__ void xcd_barrier_complete(unsigned* bar, unsigned x, unsigned& nloc, unsigned& nx) {
    const unsigned G = gridDim.x * gridDim.y * gridDim.z;
    unsigned sum, cnt, mine, sp = 0u;
    for (;;) {
        sum = 0u; cnt = 0u; mine = 0u;
#pragma unroll
        for (unsigned j = 0; j < 16; ++j) { const unsigned c = xb_ld(&bar[XB_XCNT(j)]); sum += c; cnt += (c > 0u) ? 1u : 0u; mine = (j == x) ? c : mine; }
        if (sum == G) break;
        __builtin_amdgcn_s_sleep(1);
        if ((++sp & 255u) == 0u) { if (xb_ld(&bar[XB_TMO])) break; if (sp > XB_SPIN_CAP) { atomicAdd(&bar[XB_TMO], 1u); break; } }
    }
    nloc = mine > 0u ? mine : 1u; nx = cnt > 0u ? cnt : 1u;
}
__device__ __forceinline__ void xcd_barrier(const XcdBarrier& b) {
    asm volatile("s_waitcnt vmcnt(0)" ::: "memory");
    __syncthreads();
    if (threadIdx.x == 0) {
        unsigned* bar = b.bar;
        __builtin_amdgcn_s_waitcnt(0);
        unsigned nloc = b.st[0], nx = b.st[1];
        if (nloc == 0u) { xcd_barrier_complete(bar, b.x, nloc, nx); b.st[0] = nloc; b.st[1] = nx; }
        const unsigned old = xb_add(&bar[XB_XSUB(b.x)], 1u);
        const unsigned gen = old / nloc;
        if (old + 1u == (gen + 1u) * nloc) {
            __builtin_amdgcn_fence(__ATOMIC_RELEASE, "agent");
            asm volatile("s_waitcnt vmcnt(0)" ::: "memory");
            const unsigned og = xb_add(&bar[XB_TOP], 1u);
            const unsigned tg = og / nx;
            if (og + 1u == (tg + 1u) * nx) xb_add(&bar[XB_TOPGEN], 1u);
            else XB_SPIN(xb_ld(&bar[XB_TOPGEN]) == tg, bar);
            __builtin_amdgcn_fence(__ATOMIC_ACQUIRE, "agent");
            xb_add(&bar[XB_XGEN(b.x)], 1u);
            asm volatile("s_waitcnt vmcnt(0)" ::: "memory");
        } else {
            XB_SPIN(xb_ld(&bar[XB_XGEN(b.x)]) == gen, bar);
            __builtin_amdgcn_fence(__ATOMIC_ACQUIRE, "agent");
            asm volatile("s_waitcnt vmcnt(0)" ::: "memory");
        }
    }
    __syncthreads();
}

namespace pg8 {
constexpr int BM = 256, BK = 64, HALF = 128, HTB = HALF * BK * 2, STAGE_BYTES = 8 * HTB, NXCD = 8, WGM = 8;
__host__ __device__ __forceinline__ int lds_byte(int r, int c) { const int st = (r >> 4) * 2 + (c >> 5), rr = r & 15, cc = c & 31, ob = rr * 64 + cc * 2; return st * 1024 + (ob ^ (((ob >> 9) & 1) << 5)); }
__host__ __device__ __forceinline__ void stage_rc(int b, int& R, int& C) { const int st = b / 1024, sb = b % 1024, swz = sb ^ (((sb >> 9) & 1) << 5); R = (st >> 1) * 16 + swz / 64; C = (st & 1) * 32 + (swz % 64) / 2; }
__host__ __device__ __forceinline__ int perm32(int rho) { const int n = rho >> 4, i = rho & 15; return 8 * (i >> 2) + 4 * n + (i & 3); }

struct Unit { int pm, pn, e, row0, mask; };

struct PlainSched {
    static constexpr bool A_INV = true, B_INV = true;
    const bf16_t* A; const bf16_t* Bt; int K, ldb; int nM, nN, nwg, G, c;
    __device__ void init(const bf16_t* A_, const bf16_t* Bt_, int M, int N, int K_, int G_, int c_) { A = A_; Bt = Bt_; K = K_; ldb = K_; nM = M / BM; nN = N / BM; nwg = nM * nN; G = G_; c = c_; }
    __device__ bool next(int i, Unit& u) const {
        const long L = (long)i * G + c; if (L >= nwg) return false;
        int wgid = (int)L; { const int q = nwg / NXCD, r = nwg % NXCD, xcd = wgid % NXCD, off = wgid / NXCD; wgid = (xcd < r ? xcd * (q + 1) : r * (q + 1) + (xcd - r) * q) + off; }
        const int nig = WGM * nN, gid = wgid / nig, fm = gid * WGM, gsz = (nM - fm) < WGM ? (nM - fm) : WGM;
        u.pm = fm + ((wgid % nig) % gsz); u.pn = (wgid % nig) / gsz; u.e = 0; u.row0 = 0; u.mask = 15; return true;
    }
    __device__ __forceinline__ const char* a_base(const Unit& u) const { return (const char*)A + (size_t)u.pm * BM * K * 2; }
    __device__ __forceinline__ const char* b_base(const Unit& u) const { return (const char*)Bt + (size_t)u.pn * BM * K * 2; }
    __device__ __forceinline__ void a_offs(const Unit&, const int (&R)[2], const int (&C)[2], unsigned (&o)[2][2]) const {
#pragma unroll
        for (int h = 0; h < 2; ++h)
#pragma unroll
            for (int i = 0; i < 2; ++i) o[h][i] = (unsigned)((h * HALF + R[i]) * K + C[i]) * 2u;
    }
    __device__ __forceinline__ void b_offs(const Unit&, const int (&R)[2], const int (&C)[2], unsigned (&o)[2][2]) const {
#pragma unroll
        for (int h = 0; h < 2; ++h)
#pragma unroll
            for (int i = 0; i < 2; ++i) o[h][i] = (unsigned)((h * HALF + (R[i] & ~31) + perm32(R[i] & 31)) * ldb + C[i]) * 2u;
    }
    __device__ __forceinline__ unsigned kstepA() const { return 128u; }
    __device__ __forceinline__ unsigned kstepB() const { return 128u; }
};

template <class Epi, class Sched, bool ONE_TRIP = false, bool MASKED = false>
__device__ __forceinline__ void gemm_phase(LAS unsigned char* lds, const int K, const Sched& S, const Epi& E) {
    int tid_ = threadIdx.x; asm volatile("" : "+v"(tid_));
    const int tid = tid_, wid = __builtin_amdgcn_readfirstlane(tid >> 6), lane = tid & 63, wr = wid >> 2, wc = wid & 3, fr = lane & 15, fq = lane >> 4;
    const int nt = K / BK;
    int sR[2], sC[2];
#pragma unroll
    for (int i = 0; i < 2; ++i) stage_rc(tid * 16 + i * 8192, sR[i], sC[i]);
    const size_t kA = S.kstepA(), kB = S.kstepB();
    const unsigned ldsw = (unsigned)wid * 1024u;
    const int aoff = lds_byte(wr * 64 + fr, fq * 8), boff = lds_byte(wc * 32 + fr, fq * 8);
#define PG8_SA(b, h) (((b) * 2 + (h)) * HTB)
#define PG8_SB(b, h) ((4 + (b) * 2 + (h)) * HTB)
#define PG8_GLDS(src, dstoff) __builtin_amdgcn_global_load_lds((const unsigned*)(src), (LAS unsigned*)(lds + (dstoff)), 16, 0, 0)
#define PG8_STAGE(bufoff, gbase, o0, o1) do { PG8_GLDS((const char*)(gbase) + (o0), (bufoff) + ldsw); PG8_GLDS((const char*)(gbase) + (o1), (bufoff) + ldsw + 8192); } while (0)
#define PG8_LDA(dst, b, h) do { _Pragma("unroll") for (int m = 0; m < 4; ++m) _Pragma("unroll") for (int k = 0; k < 2; ++k) dst[m][k] = *(const LAS bf16x8*)(lds + PG8_SA(b, h) + aoff + m * 2048 + k * 1024); } while (0)
#define PG8_LDB(dst, b, h) do { _Pragma("unroll") for (int n = 0; n < 2; ++n) _Pragma("unroll") for (int k = 0; k < 2; ++k) dst[n][k] = *(const LAS bf16x8*)(lds + PG8_SB(b, h) + boff + n * 2048 + k * 1024); } while (0)
#define PG8_MMA(ai, bj, At, Bt) do { __builtin_amdgcn_s_setprio(1); _Pragma("unroll") for (int m = 0; m < 4; ++m) _Pragma("unroll") for (int n = 0; n < 2; ++n) _Pragma("unroll") for (int k = 0; k < 2; ++k) \
        acc[ai][bj][m][n] = __builtin_amdgcn_mfma_f32_16x16x32_bf16(Bt[n][k], At[m][k], acc[ai][bj][m][n], 0, 0, 0); __builtin_amdgcn_s_setprio(0); } while (0)
#define PG8_MMAQ(ai, bj, At, Bt) do { if (!MASKED || ((cur.mask >> ((ai) * 2 + (bj))) & 1)) PG8_MMA(ai, bj, At, Bt); } while (0)
#define PG8_WAIT_V(n) asm volatile("s_waitcnt vmcnt(" #n ")" ::: "memory")
#define PG8_WAIT_L(n) asm volatile("s_waitcnt lgkmcnt(" #n ")" ::: "memory")
#define PG8_BAR __builtin_amdgcn_s_barrier()
#define PG8_SCHED __builtin_amdgcn_sched_barrier(0)
    Unit cur, nxt; int ui = 0;
    if (!S.next(0, cur)) return;
    f32x4 acc[2][2][4][2];
#pragma unroll
    for (int a = 0; a < 2; ++a)
#pragma unroll
        for (int b = 0; b < 2; ++b)
#pragma unroll
            for (int m = 0; m < 4; ++m)
#pragma unroll
                for (int n = 0; n < 2; ++n) acc[a][b][m][n] = (f32x4){0.f, 0.f, 0.f, 0.f};
    bf16x8 At[4][2], B0[2][2], B1[2][2];
    unsigned vc[2][2], wc_[2][2];
    S.a_offs(cur, sR, sC, vc); S.b_offs(cur, sR, sC, wc_);
    const char* cA = S.a_base(cur); const char* cB = S.b_base(cur);
    PG8_STAGE(PG8_SB(0, 0), cB, wc_[0][0], wc_[0][1]); PG8_STAGE(PG8_SB(0, 1), cB, wc_[1][0], wc_[1][1]); PG8_STAGE(PG8_SA(0, 0), cA, vc[0][0], vc[0][1]); PG8_STAGE(PG8_SA(0, 1), cA, vc[1][0], vc[1][1]);
    if (wr == 1) PG8_BAR;
    PG8_WAIT_V(2); PG8_BAR;
    PG8_STAGE(PG8_SB(1, 0), cB + kB, wc_[0][0], wc_[0][1]); PG8_STAGE(PG8_SA(1, 0), cA + kA, vc[0][0], vc[0][1]); PG8_STAGE(PG8_SB(1, 1), cB + kB, wc_[1][0], wc_[1][1]);
    PG8_WAIT_V(6); PG8_BAR;
#define PG8_TRIP(a1, a2, a3, b2, b3, C10, C11, N00, N01, N10, N11, M00, M01, M10, M11) do { \
              \
            PG8_LDB(B0, 0, 0); PG8_LDB(B1, 0, 1); PG8_SCHED; PG8_LDA(At, 0, 0); PG8_STAGE(PG8_SA(1, 1), a1, C10, C11); \
            PG8_WAIT_V(8); PG8_WAIT_L(0); PG8_BAR; PG8_MMAQ(0, 0, At, B0); PG8_MMAQ(0, 1, At, B1); PG8_BAR; PG8_SCHED; \
              \
            PG8_LDA(At, 0, 1); PG8_STAGE(PG8_SB(0, 0), b2, M00, M01); PG8_STAGE(PG8_SB(0, 1), b2, M10, M11); PG8_STAGE(PG8_SA(0, 0), a2, N00, N01); \
            PG8_WAIT_V(8); PG8_WAIT_L(0); PG8_BAR; PG8_MMAQ(1, 0, At, B0); PG8_MMAQ(1, 1, At, B1); PG8_BAR; PG8_SCHED; \
              \
            PG8_LDB(B0, 1, 0); PG8_LDB(B1, 1, 1); PG8_SCHED; PG8_LDA(At, 1, 0); PG8_STAGE(PG8_SA(0, 1), a2, N10, N11); \
            PG8_WAIT_V(8); PG8_WAIT_L(0); PG8_BAR; PG8_MMAQ(0, 0, At, B0); PG8_MMAQ(0, 1, At, B1); PG8_BAR; PG8_SCHED; \
              \
            PG8_LDA(At, 1, 1); PG8_STAGE(PG8_SB(1, 0), b3, M00, M01); PG8_STAGE(PG8_SB(1, 1), b3, M10, M11); PG8_STAGE(PG8_SA(1, 0), a3, N00, N01); \
            PG8_WAIT_V(8); PG8_WAIT_L(0); PG8_BAR; PG8_MMAQ(1, 0, At, B0); PG8_MMAQ(1, 1, At, B1); PG8_BAR; PG8_SCHED; } while (0)
    unsigned vn[2][2], wn_[2][2];
#pragma unroll
    for (int h = 0; h < 2; ++h) { vn[h][0] = vc[h][0]; vn[h][1] = vc[h][1]; wn_[h][0] = wc_[h][0]; wn_[h][1] = wc_[h][1]; }
    for (;;) {
        const bool has_next = S.next(ui + 1, nxt);
        const char* nA = has_next ? S.a_base(nxt) : cA; const char* nB = has_next ? S.b_base(nxt) : cB;
        if constexpr (ONE_TRIP) {
            if (has_next) { if constexpr (!Sched::A_INV) S.a_offs(nxt, sR, sC, vn); if constexpr (!Sched::B_INV) S.b_offs(nxt, sR, sC, wn_); }
            PG8_TRIP(cA + kA, nA, nA + kA, nB, nB + kB, vc[1][0], vc[1][1], vn[0][0], vn[0][1], vn[1][0], vn[1][1], wn_[0][0], wn_[0][1], wn_[1][0], wn_[1][1]);
        } else {
            for (int t = 0; t < nt; t += 2) {
                const bool last = (t == nt - 2);
                if (last && has_next) { if constexpr (!Sched::A_INV) S.a_offs(nxt, sR, sC, vn); if constexpr (!Sched::B_INV) S.b_offs(nxt, sR, sC, wn_); }
                const char* a1 = cA + (size_t)(t + 1) * kA;
                const char* a2 = last ? nA : cA + (size_t)(t + 2) * kA; const char* b2 = last ? nB : cB + (size_t)(t + 2) * kB;
                const char* a3 = a2 + kA; const char* b3 = b2 + kB;
                const bool la = last && !Sched::A_INV, lb = last && !Sched::B_INV;
                const unsigned x00 = la ? vn[0][0] : vc[0][0], x01 = la ? vn[0][1] : vc[0][1], x10 = la ? vn[1][0] : vc[1][0], x11 = la ? vn[1][1] : vc[1][1];
                const unsigned y00 = lb ? wn_[0][0] : wc_[0][0], y01 = lb ? wn_[0][1] : wc_[0][1], y10 = lb ? wn_[1][0] : wc_[1][0], y11 = lb ? wn_[1][1] : wc_[1][1];
                PG8_TRIP(a1, a2, a3, b2, b3, vc[1][0], vc[1][1], x00, x01, x10, x11, y00, y01, y10, y11);
            }
        }
#pragma unroll
        for (int h = 0; h < 2; ++h) { vc[h][0] = vn[h][0]; vc[h][1] = vn[h][1]; wc_[h][0] = wn_[h][0]; wc_[h][1] = wn_[h][1]; }
        if (wr == 0) PG8_BAR;
        E(acc, cur, wr, wc, fr, fq);
        if (!has_next) break;
#pragma unroll
        for (int a = 0; a < 2; ++a)
#pragma unroll
            for (int b = 0; b < 2; ++b)
#pragma unroll
                for (int m = 0; m < 4; ++m)
#pragma unroll
                    for (int n = 0; n < 2; ++n) acc[a][b][m][n] = (f32x4){0.f, 0.f, 0.f, 0.f};
        cur = nxt; cA = nA; cB = nB; ++ui;
        if (wr == 1) PG8_BAR;
    }
    PG8_WAIT_V(0);
    PG8_BAR;
#undef PG8_SA
#undef PG8_SB
#undef PG8_GLDS
#undef PG8_STAGE
#undef PG8_TRIP
#undef PG8_LDA
#undef PG8_LDB
#undef PG8_MMA
#undef PG8_MMAQ
#undef PG8_WAIT_V
#undef PG8_WAIT_L
#undef PG8_BAR
#undef PG8_SCHED
}
}

struct Args { const float* in[18]; float* out; unsigned char* ws; int ph_lo, ph_hi, rep, pad; };

__device__ __forceinline__ void p0_adaln(const Args& a, LAS unsigned char* lds, float* mod) {
    const int tid = threadIdx.x;
    LAS float* sc = (LAS float*)lds;
    LAS float* red = (LAS float*)(lds + 16384);
    const float* c = a.in[1]; const float* ada_w = a.in[3]; const float* ada_b = a.in[4];
    for (int i = tid; i < 4096; i += NTHR) { const float v = c[i]; sc[i] = v / (1.f + expf(-v)); }
    __syncthreads();
    const int r = tid / 24, c4 = tid % 24;
    for (int cg = blockIdx.x; cg < 256; cg += gridDim.x) {
        const int idx = cg >> 6, col0 = (cg & 63) * 96;
        const float* W = ada_w + (size_t)idx * 2048 * 6144 + col0 + c4 * 4;
        f32x4 a0 = {0.f, 0.f, 0.f, 0.f}, a1 = {0.f, 0.f, 0.f, 0.f};
        if (tid < 504) {
            int k = r;
            for (; k + 63 < 2048; k += 84) {
                const f32x4 w0 = __builtin_nontemporal_load((const f32x4*)(W + (size_t)k * 6144)), w1 = __builtin_nontemporal_load((const f32x4*)(W + (size_t)(k + 21) * 6144)), w2 = __builtin_nontemporal_load((const f32x4*)(W + (size_t)(k + 42) * 6144)), w3 = __builtin_nontemporal_load((const f32x4*)(W + (size_t)(k + 63) * 6144));
                a0 += sc[k] * w0; a1 += sc[2048 + k] * w0; a0 += sc[k + 21] * w1; a1 += sc[2048 + k + 21] * w1;
                a0 += sc[k + 42] * w2; a1 += sc[2048 + k + 42] * w2; a0 += sc[k + 63] * w3; a1 += sc[2048 + k + 63] * w3;
            }
            for (; k < 2048; k += 21) { const f32x4 w0 = *(const f32x4*)(W + (size_t)k * 6144); a0 += sc[k] * w0; a1 += sc[2048 + k] * w0; }
            *(LAS f32x4*)(red + (r * 24 + c4) * 8) = a0; *(LAS f32x4*)(red + (r * 24 + c4) * 8 + 4) = a1;
        }
        __syncthreads();
        if (tid < 192) {
            const int cc4 = tid >> 3, j = tid & 7; float s = 0.f;
            for (int rr = 0; rr < 21; ++rr) s += red[(rr * 24 + cc4) * 8 + j];
            const int b = j >> 2, col = col0 + cc4 * 4 + (j & 3);
            mod[(idx * 2 + b) * 6144 + col] = s + ada_b[idx * 6144 + col];
        }
        __syncthreads();
    }
}

struct TJob { const float* src; bf16_t* dst; int K, N, rowmode, k0, n0; };
__device__ __forceinline__ TJob p0_job(const Args& a, int t) {
    unsigned char* ws = a.ws; TJob j; int tk, tn;
    if (t < 4608) { j = TJob{a.in[5], (bf16_t*)(ws + WS_WQKV), 2048, 18432, 0, 0, 0}; tk = t / 288; tn = t % 288; }
    else if (t < 6144) { const int q = t - 4608, w = q / 512, r = q % 512; j = TJob{a.in[6 + w], (bf16_t*)(ws + WS_WO + (size_t)w * 8 * MB), 2048, 2048, 0, 0, 0}; tk = r / 32; tn = r % 32; }
    else if (t < 22528) { const int q = t - 6144, up = q / 8192, r = q % 8192, mat = r / 128, rr = r % 128;
        j = TJob{a.in[15 + up] + (size_t)mat * 2048 * 512, (bf16_t*)(ws + WS_WGU) + (size_t)mat * 1024 * 2048, 2048, 512, 1 + up, 0, 0}; tk = rr / 8; tn = rr % 8; }
    else { const int r = t - 22528, mat = r / 128, rr = r % 128; j = TJob{a.in[17] + (size_t)mat * 512 * 2048, (bf16_t*)(ws + WS_WD) + (size_t)mat * 2048 * 512, 512, 2048, 0, 0, 0}; tk = rr / 32; tn = rr % 32; }
    j.k0 = tk * 128; j.n0 = tn * 64; return j;
}
__device__ __forceinline__ void p0_tile_load(const TJob& j, int tid, f32x4 (&f)[2][2]) {
#pragma unroll
    for (int i = 0; i < 2; ++i) { const int p = i * 32 + (tid >> 4), c = (tid & 15) * 4;
        f[i][0] = __builtin_nontemporal_load((const f32x4*)(j.src + (size_t)(j.k0 + 2 * p) * j.N + j.n0 + c)); f[i][1] = __builtin_nontemporal_load((const f32x4*)(j.src + (size_t)(j.k0 + 2 * p + 1) * j.N + j.n0 + c)); }
}
__device__ __forceinline__ void p0_transposes(const Args& a, LAS unsigned char* lds) {
    const int tid = threadIdx.x; LAS unsigned* T2 = (LAS unsigned*)lds;
    int t = blockIdx.x; if (t >= 30720) return;
    TJob j = p0_job(a, t); f32x4 f[2][2];
    p0_tile_load(j, tid, f);
    for (;;) {
        __syncthreads();
#pragma unroll
        for (int i = 0; i < 2; ++i) { const int p = i * 32 + (tid >> 4), c = (tid & 15) * 4;
#pragma unroll
            for (int e = 0; e < 4; ++e) T2[p * 65 + c + e] = pack_bf16(f[i][0][e], f[i][1][e]); }
        const TJob cur = j; const int tn = t + gridDim.x; const bool more = tn < 30720;
        if (more) { j = p0_job(a, tn); p0_tile_load(j, tid, f); }
        __syncthreads();
        const int n = tid >> 3, x = tid & 7;
        unsigned d[8];
#pragma unroll
        for (int jj = 0; jj < 8; ++jj) d[jj] = T2[(8 * x + jj) * 65 + n];
        const int nn = cur.n0 + n;
        const int row = cur.rowmode == 0 ? nn : ((nn >> 4) * 32 + (nn & 15) + (cur.rowmode == 2 ? 16 : 0));
        bf16_t* dp = cur.dst + (size_t)row * cur.K + cur.k0 + 16 * x;
        if (t >= 6144) { __builtin_nontemporal_store((u32x4){d[0], d[1], d[2], d[3]}, (u32x4*)dp); __builtin_nontemporal_store((u32x4){d[4], d[5], d[6], d[7]}, (u32x4*)(dp + 8)); }
        else { *(u32x4*)dp = (u32x4){d[0], d[1], d[2], d[3]}; *(u32x4*)(dp + 8) = (u32x4){d[4], d[5], d[6], d[7]}; }
        if (!more) break;
        t = tn;
    }
    __syncthreads();
}
__device__ __forceinline__ void p0_tables(const Args& a, float* rot) {
    const int* pos = (const int*)a.in[2];
    for (int i = blockIdx.x * NTHR + threadIdx.x; i < T * 16; i += gridDim.x * NTHR) {
        const int t = i >> 4, j = i & 15;
        const float invf = (float)pow(500000.0, -(double)j / 16.0);
        const float ang = (float)pos[t] * invf;
        double r = (double)ang * 0.31830988618379067154; r -= 2.0 * rint(r * 0.5);
        float s, c; sincospif((float)r, &s, &c);
        rot[t * 32 + j] = c; rot[t * 32 + 16 + j] = s;
    }
}
__device__ __forceinline__ void p_modulate(const float* __restrict__ x, const float* __restrict__ mod, bf16_t* __restrict__ h) {
    for (size_t i = (size_t)blockIdx.x * NTHR + threadIdx.x; i < (size_t)T * D / 8; i += (size_t)gridDim.x * NTHR) {
        const size_t e = i * 8; const int t = (int)(e >> 11), d = (int)(e & 2047), b = t >> 12;
        const f32x4 x0 = *(const f32x4*)(x + e), x1 = *(const f32x4*)(x + e + 4);
        const float* m = mod + b * 6144 + d;
        const f32x4 sh0 = *(const f32x4*)m, sh1 = *(const f32x4*)(m + 4), sc0 = *(const f32x4*)(m + 2048), sc1 = *(const f32x4*)(m + 2052);
        const f32x4 y0 = x0 * (1.f + sc0) + sh0, y1 = x1 * (1.f + sc1) + sh1;
        *(u32x4*)(h + e) = (u32x4){pack_bf16(y0[0], y0[1]), pack_bf16(y0[2], y0[3]), pack_bf16(y1[0], y1[1]), pack_bf16(y1[2], y1[3])};
    }
}
struct QkvSched {
    static constexpr bool A_INV = true, B_INV = false;
    const unsigned char* ws; int G, c;
    __device__ static void grid_map(int wgid, int nM, int nN, int& pm, int& pn) {
        const int nwg = nM * nN; { const int q = nwg / pg8::NXCD, r = nwg % pg8::NXCD, xcd = wgid % pg8::NXCD, off = wgid / pg8::NXCD; wgid = (xcd < r ? xcd * (q + 1) : r * (q + 1) + (xcd - r) * q) + off; }
        const int nig = pg8::WGM * nN, gid = wgid / nig, fm = gid * pg8::WGM, gsz = (nM - fm) < pg8::WGM ? (nM - fm) : pg8::WGM;
        pm = fm + ((wgid % nig) % gsz); pn = (wgid % nig) / gsz;
    }
    __device__ bool next(int i, pg8::Unit& u) const {
        const int L = i * G + c; if (L >= 2304) return false;
        if (L < 1536) { grid_map(L, 32, 48, u.pm, u.pn); u.e = 0; const int g = u.pn >> 4, which = (u.pn >> 3) & 1; u.row0 = g * 6144 + which * 2048 + (u.pn & 7) * 256; }
        else { grid_map(L - 1536, 24, 32, u.pm, u.pn); u.e = 1; const int g = u.pm >> 3; u.row0 = g * 6144 + 4096 + (u.pm & 7) * 256; }
        u.mask = 15; return true;
    }
    __device__ __forceinline__ const char* a_base(const pg8::Unit& u) const { return (const char*)ws + (u.e == 0 ? WS_H + (size_t)u.pm * 256 * 2048 * 2 : WS_WQKV + (size_t)u.row0 * 2048 * 2); }
    __device__ __forceinline__ const char* b_base(const pg8::Unit& u) const { return (const char*)ws + (u.e == 0 ? WS_WQKV + (size_t)u.row0 * 2048 * 2 : WS_H); }
    __device__ __forceinline__ void a_offs(const pg8::Unit&, const int (&R)[2], const int (&C)[2], unsigned (&o)[2][2]) const {
#pragma unroll
        for (int h = 0; h < 2; ++h)
#pragma unroll
            for (int i = 0; i < 2; ++i) o[h][i] = (unsigned)((h * 128 + R[i]) * 2048 + C[i]) * 2u; }
    __device__ __forceinline__ void b_offs(const pg8::Unit& u, const int (&R)[2], const int (&C)[2], unsigned (&o)[2][2]) const {
        const int sh = (u.pm >> 3) * 2;
#pragma unroll
        for (int h = 0; h < 2; ++h)
#pragma unroll
            for (int i = 0; i < 2; ++i) {
                if (u.e == 0) o[h][i] = (unsigned)((h * 128 + R[i]) * 2048 + C[i]) * 2u;
                else { const int n = (u.pn & 15) * 256 + h * 128 + (R[i] & ~31) + pg8::perm32(R[i] & 31);
                    const int lg = 12 - sh, r = n >> lg, j = n & ((1 << lg) - 1), t = (u.pn >> 4) * 4096 + r + (j << sh); o[h][i] = (unsigned)(t * 2048 + C[i]) * 2u; }
            } }
    __device__ __forceinline__ unsigned kstepA() const { return 128u; }
    __device__ __forceinline__ unsigned kstepB() const { return 128u; }
};
struct EpiQKV {
    bf16_t* Qf; bf16_t* Kf; bf16_t* Vf; const float* rot;
    __device__ __forceinline__ void operator()(const f32x4 (&acc)[2][2][4][2], const pg8::Unit& u, int wr, int wc, int fr_, int fq_) const {
        int fr = fr_, fq = fq_; asm volatile("" : "+v"(fr), "+v"(fq));
        if (u.e == 0) {
            const int g = u.pn >> 4, which = (u.pn >> 3) & 1, head0 = (u.pn & 7) * 2, sh = g * 2, nbr = 128 >> sh;
            bf16_t* dst = Qf + (size_t)which * ((WS_KF - WS_QF) / 2);
#pragma unroll
            for (int ai = 0; ai < 2; ++ai)
#pragma unroll
                for (int m = 0; m < 4; ++m) {
                    const int row = u.pm * 256 + ai * 128 + wr * 64 + m * 16 + fr, b = row >> 12, s = row & 4095;
                    const int r = s & ((1 << sh) - 1), j = s >> sh, jo = j & 31, blk = r * nbr + (j >> 5);
                    f32x4 cs = {1.f, 1.f, 1.f, 1.f}, sn = {0.f, 0.f, 0.f, 0.f};
                    if (wc == 0) { const float* rp = rot + (size_t)row * 32 + 4 * fq; cs = *(const f32x4*)rp; sn = *(const f32x4*)(rp + 16); }
                    const int c = 4 * wc + fq, ks = c >> 1, hh = c & 1, lanepos = which == 0 ? jo : pi32(jo);
#pragma unroll
                    for (int bj = 0; bj < 2; ++bj) {
                        const size_t blkid = (size_t)(((g * 2 + b) * 16 + head0 + bj) * 128 + blk);
                        f32x4 v0 = acc[ai][bj][m][0], v1 = acc[ai][bj][m][1];
                        if (wc == 0) { const f32x4 t0 = v0 * cs - v1 * sn, t1 = v1 * cs + v0 * sn; v0 = t0; v1 = t1; }
                        if (which == 0) { v0 *= QSCALE; v1 *= QSCALE; }
                        *(u32x4*)(dst + ((blkid * 8 + ks) * 64 + hh * 32 + lanepos) * 8) = (u32x4){pack_bf16(v0[0], v0[1]), pack_bf16(v0[2], v0[3]), pack_bf16(v1[0], v1[1]), pack_bf16(v1[2], v1[3])};
                    }
                }
        } else {
            const int g = u.pm >> 3, sh = g * 2, nbr = 128 >> sh, lg = 12 - sh, b = u.pn >> 4;
#pragma unroll
            for (int bj = 0; bj < 2; ++bj) {
                const int n0 = (u.pn & 15) * 256 + bj * 128 + wc * 32 + 8 * fq, r = n0 >> lg, j0 = n0 & ((1 << lg) - 1), jo = j0 & 31, blk = r * nbr + (j0 >> 5);
#pragma unroll
                for (int ai = 0; ai < 2; ++ai)
#pragma unroll
                    for (int m = 0; m < 4; ++m) {
                        const int f = (u.pm & 7) * 256 + ai * 128 + wr * 64 + m * 16 + fr, head = f >> 7, d = f & 127;
                        const size_t blkid = (size_t)(((g * 2 + b) * 16 + head) * 128 + blk);
                        const f32x4 v0 = acc[ai][bj][m][0], v1 = acc[ai][bj][m][1];
                        *(u32x4*)(Vf + ((blkid * 8 + (d >> 5) * 2 + (jo >> 4)) * 64 + ((jo >> 3) & 1) * 32 + (d & 31)) * 8) = (u32x4){pack_bf16(v0[0], v0[1]), pack_bf16(v0[2], v0[3]), pack_bf16(v1[0], v1[1]), pack_bf16(v1[2], v1[3])};
                    }
            }
        }
    }
};

__device__ __forceinline__ void attn_load(const bf16_t* __restrict__ F, const size_t kblk, const int lane, bf16x8 (&f)[8]) {
    unsigned lo8 = 8u * (unsigned)lane; asm volatile("" : "+v"(lo8));
    const bf16_t* p = F + kblk * 4096;
#pragma unroll
    for (int ks = 0; ks < 8; ++ks) f[ks] = *(const bf16x8*)(p + ks * 512 + lo8);
}
__device__ __forceinline__ void attn_block(const int rel  , const bool more, const int qo, const int hh, const bf16x8 (&qf)[8], bf16x8 (&kf)[8], const bf16_t* __restrict__ Kf, const bf16_t* __restrict__ Vf, const size_t kblk, const int lane, f32x16 (&O)[4], float& m, float& l) {
    bf16x8 vf[8]; attn_load(Vf, kblk, lane, vf);
    f32x16 S;
#pragma unroll
    for (int e = 0; e < 16; ++e) S[e] = 0.f;
#pragma unroll
    for (int ks = 0; ks < 8; ++ks) S = __builtin_amdgcn_mfma_f32_32x32x16_bf16(kf[ks], qf[ks], S, 0, 0, 0);
    if (more) attn_load(Kf, kblk + 1, lane, kf);
    if (rel == -2) {
#pragma unroll
        for (int e = 0; e < 16; ++e) { const int ko = 16 * (e >> 3) + 8 * hh + (e & 7); if (ko < qo) S[e] = -1e30f; }
    }
    if (rel == 2) {
#pragma unroll
        for (int e = 0; e < 16; ++e) { const int ko = 16 * (e >> 3) + 8 * hh + (e & 7); if (ko > qo) S[e] = -1e30f; }
    }
    float bm = S[0];
#pragma unroll
    for (int e = 1; e < 16; ++e) bm = fmaxf(bm, S[e]);
    bm = fmaxf(bm, __shfl_xor(bm, 32));
    const float mn = fmaxf(m, bm), alpha = exp2f(m - mn);
    float ls = 0.f;
#pragma unroll
    for (int e = 0; e < 16; ++e) { S[e] = exp2f(S[e] - mn); ls += S[e]; }
    l = l * alpha + ls; m = mn;
#pragma unroll
    for (int db = 0; db < 4; ++db)
#pragma unroll
        for (int e = 0; e < 16; ++e) O[db][e] *= alpha;
    bf16x8 pf[2];
#pragma unroll
    for (int s2 = 0; s2 < 2; ++s2) { u32x4 w = {pack_bf16(S[8 * s2], S[8 * s2 + 1]), pack_bf16(S[8 * s2 + 2], S[8 * s2 + 3]), pack_bf16(S[8 * s2 + 4], S[8 * s2 + 5]), pack_bf16(S[8 * s2 + 6], S[8 * s2 + 7])};
        pf[s2] = __builtin_bit_cast(bf16x8, w); }
#pragma unroll
    for (int db = 0; db < 4; ++db)
#pragma unroll
        for (int s2 = 0; s2 < 2; ++s2) O[db] = __builtin_amdgcn_mfma_f32_32x32x16_bf16(vf[db * 2 + s2], pf[s2], O[db], 0, 0, 0);
}
constexpr int ATT_ROWB = 264;
__device__ __forceinline__ void p_attention(LAS unsigned char* lds, const bf16_t* __restrict__ Qf, const bf16_t* __restrict__ Kf, const bf16_t* __restrict__ Vf, bf16_t* __restrict__ o) {
    const int tid = threadIdx.x, lane = tid & 63, wave = __builtin_amdgcn_readfirstlane(tid >> 6);
    const int qo = lane & 31, hh = lane >> 5;
    LAS unsigned char* osh = lds; LAS float* lsh = (LAS float*)(lds + 512 * ATT_ROWB);
    const int vb = (gridDim.x & 7) ? (int)blockIdx.x : (int)(blockIdx.x & 7) * (int)(gridDim.x >> 3) + (int)(blockIdx.x >> 3);
    for (int unit = vb; unit < 256; unit += gridDim.x) {
        const int b = unit >> 7, head = (unit >> 3) & 15, span = unit & 7;
#pragma unroll 1
        for (int g = 0; g < 3; ++g) {
            const int sh = g * 2, nbr = 128 >> sh, nper = 16 >> sh;
            const size_t base = (size_t)(((g * 2 + b) * 16 + head) * 128);
#pragma unroll 1
            for (int rep = 0; rep < 2; ++rep) {
                const int it = wave + 8 * rep, r = it / nper, jb = span * nper + it % nper, blk = r * nbr + jb;
                const int lo = jb - 2 < 0 ? 0 : jb - 2, hi = jb + 2 > nbr - 1 ? nbr - 1 : jb + 2;
                const size_t kb0 = base + r * nbr;
                bf16x8 kf[8];
                attn_load(Kf, kb0 + lo, lane, kf);
                bf16x8 qf[8];
                attn_load(Qf, base + blk, lane, qf);
                f32x16 O[4];
#pragma unroll
                for (int db = 0; db < 4; ++db)
#pragma unroll
                    for (int e = 0; e < 16; ++e) O[db][e] = 0.f;
                float m = -1e30f, l = 0.f;
                for (int kb = lo; kb <= hi; ++kb) attn_block(kb - jb, kb < hi, qo, hh, qf, kf, Kf, Vf, kb0 + kb, lane, O, m, l);
                const float lt = l + __shfl_xor(l, 32), lse2 = m + log2f(lt);
                const int tl = r + ((32 * jb + qo) << sh) - span * 512;
                LAS unsigned char* rowp = osh + tl * ATT_ROWB + 8 * hh;
                float a0 = 0.f, a1 = 1.f / lt;
                if (g != 0) { const float lold = lsh[tl], m2 = fmaxf(lold, lse2), w0 = exp2f(lold - m2), w1 = exp2f(lse2 - m2), inv2 = 1.f / (w0 + w1);
                    a0 = w0 * inv2; a1 *= w1 * inv2; if (hh == 0) lsh[tl] = m2 + log2f(w0 + w1); }
                else if (hh == 0) lsh[tl] = lse2;
#pragma unroll
                for (int db = 0; db < 4; ++db)
#pragma unroll
                    for (int q4 = 0; q4 < 4; ++q4) {
                        LAS u32x2* p = (LAS u32x2*)(rowp + 64 * db + 16 * q4);
                        float v0 = O[db][4 * q4] * a1, v1 = O[db][4 * q4 + 1] * a1, v2 = O[db][4 * q4 + 2] * a1, v3 = O[db][4 * q4 + 3] * a1;
                        if (g != 0) { const u32x2 old = *p; v0 += a0 * __uint_as_float(old[0] << 16); v1 += a0 * __uint_as_float(old[0] & 0xffff0000u); v2 += a0 * __uint_as_float(old[1] << 16); v3 += a0 * __uint_as_float(old[1] & 0xffff0000u); }
                        *p = (u32x2){pack_bf16(v0, v1), pack_bf16(v2, v3)};
                    }
            }
            __syncthreads();
        }
        bf16_t* ob = o + ((size_t)(b * SEQ + span * 512)) * D + head * 128;
#pragma unroll 4
        for (int i2 = 0; i2 < 32; ++i2) { const int row = i2 * 16 + (tid >> 5), c = tid & 31;
            *(u32x2*)(ob + (size_t)row * D + c * 4) = *(const LAS u32x2*)(osh + row * ATT_ROWB + c * 8); }
        __syncthreads();
    }
}
__device__ __forceinline__ void p_combine(const bf16_t* __restrict__ og, const float* __restrict__ lse, bf16_t* __restrict__ o) {
    for (size_t i = (size_t)blockIdx.x * NTHR + threadIdx.x; i < (size_t)T * D / 8; i += (size_t)gridDim.x * NTHR) {
        const size_t e = i * 8; const int t = (int)(e >> 11), head = (int)((e & 2047) >> 7);
        const float l0 = lse[((size_t)0 * T + t) * 16 + head], l1 = lse[((size_t)1 * T + t) * 16 + head], l2 = lse[((size_t)2 * T + t) * 16 + head];
        const float mx = fmaxf(l0, fmaxf(l1, l2));
        float w0 = exp2f(l0 - mx), w1 = exp2f(l1 - mx), w2 = exp2f(l2 - mx); const float inv = 1.f / (w0 + w1 + w2); w0 *= inv; w1 *= inv; w2 *= inv;
        const u32x4 a0 = *(const u32x4*)(og + e), a1 = *(const u32x4*)(og + (size_t)T * D + e), a2 = *(const u32x4*)(og + (size_t)2 * T * D + e);
        u32x4 res;
#pragma unroll
        for (int k = 0; k < 4; ++k) {
            const float lo = w0 * __uint_as_float(a0[k] << 16) + w1 * __uint_as_float(a1[k] << 16) + w2 * __uint_as_float(a2[k] << 16);
            const float hi = w0 * __uint_as_float(a0[k] & 0xffff0000u) + w1 * __uint_as_float(a1[k] & 0xffff0000u) + w2 * __uint_as_float(a2[k] & 0xffff0000u);
            res[k] = pack_bf16(lo, hi);
        }
        *(u32x4*)(o + e) = res;
    }
}


constexpr size_t WS_Y = WS_QF;
constexpr size_t WS_ACT = WS_Y + 32 * MB;
constexpr size_t WS_YB = WS_ACT + 24 * MB;
constexpr size_t WS_U = WS_YB + 64 * MB;
constexpr size_t WS_ABT = WS_U + 32 * MB;
constexpr size_t WS_YF = WS_ABT + 64 * MB;
constexpr size_t WS_X1 = WS_FAST_END;
constexpr size_t WS_X2 = WS_X1 + 64 * MB;
constexpr size_t WS_T2 = WS_YF + 32 * MB;
constexpr size_t WS_D12 = WS_X2 + 64 * MB;
constexpr size_t WS_END2 = WS_D12 + 5 * MB;
static_assert(WS_T2 + 64 * MB <= WS_FAST_END, "overlay");
constexpr int LDS_TB = LDS_MISC + 64;

struct EpiBf16 {
    bf16_t* O; int ldc; float scale; int mode;
    __device__ __forceinline__ void operator()(const f32x4 (&acc)[2][2][4][2], const pg8::Unit& u, int wr, int wc, int fr, int fq) const {
        bf16_t* base = O + (mode == 1 ? (size_t)u.e * 1024 * 4096 : (size_t)0);
        const int row0 = u.pm * 256 + wr * 64 + fr, col0 = u.pn * 256 + wc * 32 + 8 * fq;
#pragma unroll
        for (int ai = 0; ai < 2; ++ai)
#pragma unroll
            for (int m = 0; m < 4; ++m) { bf16_t* rowp = base + (size_t)(row0 + ai * 128 + m * 16) * ldc + col0;
#pragma unroll
                for (int bj = 0; bj < 2; ++bj) { const f32x4 v0 = acc[ai][bj][m][0] * scale, v1 = acc[ai][bj][m][1] * scale;
                    *(u32x4*)(rowp + bj * 128) = (u32x4){pack_bf16(v0[0], v0[1]), pack_bf16(v0[2], v0[3]), pack_bf16(v1[0], v1[1]), pack_bf16(v1[2], v1[3])}; } }
    }
};

template <int NY, bool LAST>
__device__ __forceinline__ void row_ln(const int row, const int lane, const float* __restrict__ xin, const bf16_t* __restrict__ y0, const bf16_t* __restrict__ y1, const float* __restrict__ modg,
                                       const float* __restrict__ lnw, const float* __restrict__ lnb, float* __restrict__ xout, const float* __restrict__ modn, bf16_t* __restrict__ hout, f32x4 (&h)[8]) {
    const int b = row >> 12; unsigned lo4 = 4u * (unsigned)lane;
    asm volatile("" : "+v"(lo4));
    const float* xr = xin + (size_t)row * D; const bf16_t* y0r = y0 + (size_t)row * D; const bf16_t* y1r = y1 + (size_t)row * D; const float* gr = modg + b * 6144 + 4096;
    f32x4 z[8]; float sum = 0.f;
#pragma unroll
    for (int i = 0; i < 8; ++i) {
        const f32x4 xv = __builtin_nontemporal_load((const f32x4*)(xr + 256 * i + lo4)); const f32x4 gt = *(const f32x4*)(gr + 256 * i + lo4);
        const u32x2 ya = __builtin_nontemporal_load((const u32x2*)(y0r + 256 * i + lo4));
        f32x4 yv = {__uint_as_float(ya[0] << 16), __uint_as_float(ya[0] & 0xffff0000u), __uint_as_float(ya[1] << 16), __uint_as_float(ya[1] & 0xffff0000u)};
        if (NY == 2) { const u32x2 yb = __builtin_nontemporal_load((const u32x2*)(y1r + 256 * i + lo4)); yv += (f32x4){__uint_as_float(yb[0] << 16), __uint_as_float(yb[0] & 0xffff0000u), __uint_as_float(yb[1] << 16), __uint_as_float(yb[1] & 0xffff0000u)}; }
        z[i] = ALPHA * xv + gt * yv; sum += (z[i][0] + z[i][1]) + (z[i][2] + z[i][3]); }
#pragma unroll
    for (int o2 = 32; o2 >= 1; o2 >>= 1) sum += __shfl_xor(sum, o2);
    const float mean = sum * (1.f / D); float q = 0.f;
#pragma unroll
    for (int i = 0; i < 8; ++i) { const f32x4 dd = z[i] - mean; q += (dd[0] * dd[0] + dd[1] * dd[1]) + (dd[2] * dd[2] + dd[3] * dd[3]); }
#pragma unroll
    for (int o2 = 32; o2 >= 1; o2 >>= 1) q += __shfl_xor(q, o2);
    const float rstd = 1.0f / sqrtf(q * (1.f / D) + LN_EPS);
    float* xo_r = xout + (size_t)row * D; bf16_t* ho_r = hout + (size_t)row * D; const float* shr = modn + b * 6144; const float* scr = modn + b * 6144 + 2048;
#pragma unroll
    for (int i = 0; i < 8; ++i) {
        const f32x4 xo = (z[i] - mean) * rstd * *(const f32x4*)(lnw + 256 * i + lo4) + *(const f32x4*)(lnb + 256 * i + lo4);
        __builtin_nontemporal_store(xo, (f32x4*)(xo_r + 256 * i + lo4));
        if (!LAST) { const f32x4 hv = xo * (1.f + *(const f32x4*)(scr + 256 * i + lo4)) + *(const f32x4*)(shr + 256 * i + lo4);
            *(u32x2*)(ho_r + 256 * i + lo4) = (u32x2){pack_bf16(hv[0], hv[1]), pack_bf16(hv[2], hv[3])}; h[i] = hv; }
        if ((i & 3) == 3) __builtin_amdgcn_sched_barrier(0); }
}
#define LDS6(w, addr, o0) asm volatile("ds_read_b128 %0, %6 offset:%7\n\tds_read_b128 %1, %6 offset:%8\n\tds_read_b128 %2, %6 offset:%9\n\tds_read_b128 %3, %6 offset:%10\n\tds_read_b128 %4, %6 offset:%11\n\tds_read_b128 %5, %6 offset:%12\n\ts_waitcnt lgkmcnt(0)" \
    : "=&v"(w[0]), "=&v"(w[1]), "=&v"(w[2]), "=&v"(w[3]), "=&v"(w[4]), "=&v"(w[5]) : "v"(addr), "i"(o0), "i"((o0) + 2048), "i"((o0) + 4096), "i"((o0) + 6144), "i"((o0) + 8192), "i"((o0) + 10240) : "memory")
template <int Q>
__device__ __forceinline__ void router_round(LAS float* wT, const int tid, const int lane, const float* __restrict__ wr1, const float* __restrict__ wr2, const f32x4 (&h0)[8], const f32x4 (&h1)[8], float (&acc0)[36], float (&acc1)[36]) {
    __syncthreads();
#pragma unroll 1
    for (int id = tid; id < 512 * 9; id += NTHR) { const int kl = id / 9, f = id % 9, k = Q * 512 + kl;
        const f32x4 w = f == 0 ? *(const f32x4*)(wr1 + k * 4) : *(const f32x4*)(wr2 + k * 32 + (f - 1) * 4); const int c0 = f == 0 ? 0 : 4 * f;
        wT[(c0 + 0) * 512 + kl] = w[0]; wT[(c0 + 1) * 512 + kl] = w[1]; wT[(c0 + 2) * 512 + kl] = w[2]; wT[(c0 + 3) * 512 + kl] = w[3]; }
    __syncthreads();
    unsigned a0 = (unsigned)(size_t)wT + 16u * (unsigned)lane; asm volatile("" : "+v"(a0)); const unsigned a1 = a0 + 24u * 2048u;
#define RR_GROUP(ha, hb, base, c6, off) do { f32x4 w[6]; LDS6(w, base, off); _Pragma("unroll") for (int c = 0; c < 6; ++c) { \
        acc0[(c6) + c] += (ha[0] * w[c][0] + ha[1] * w[c][1]) + (ha[2] * w[c][2] + ha[3] * w[c][3]); acc1[(c6) + c] += (hb[0] * w[c][0] + hb[1] * w[c][1]) + (hb[2] * w[c][2] + hb[3] * w[c][3]); } \
        asm volatile("" : "+v"(acc0[(c6)]), "+v"(acc0[(c6) + 1]), "+v"(acc0[(c6) + 2]), "+v"(acc0[(c6) + 3]), "+v"(acc0[(c6) + 4]), "+v"(acc0[(c6) + 5]), \
                          "+v"(acc1[(c6)]), "+v"(acc1[(c6) + 1]), "+v"(acc1[(c6) + 2]), "+v"(acc1[(c6) + 3]), "+v"(acc1[(c6) + 4]), "+v"(acc1[(c6) + 5])); } while (0)
    { const f32x4 ha = h0[2 * Q], hb = h1[2 * Q];
      RR_GROUP(ha, hb, a0, 0, 0); RR_GROUP(ha, hb, a0, 6, 12288); RR_GROUP(ha, hb, a0, 12, 24576); RR_GROUP(ha, hb, a0, 18, 36864); RR_GROUP(ha, hb, a1, 24, 0); RR_GROUP(ha, hb, a1, 30, 12288); }
    { const f32x4 ha = h0[2 * Q + 1], hb = h1[2 * Q + 1];
      RR_GROUP(ha, hb, a0, 0, 1024); RR_GROUP(ha, hb, a0, 6, 13312); RR_GROUP(ha, hb, a0, 12, 25600); RR_GROUP(ha, hb, a0, 18, 37888); RR_GROUP(ha, hb, a1, 24, 1024); RR_GROUP(ha, hb, a1, 30, 13312); }
#undef RR_GROUP
}
template <int NLO, int NHI, int BIT>
__device__ __forceinline__ void rs_level(const float (&r)[NLO + NHI], float (&o)[NLO], const int lane) {
    const bool hi = (lane >> BIT) & 1;
#pragma unroll
    for (int c = 0; c < NLO; ++c) { const float lov = r[c], hiv = c < NHI ? r[c + NLO] : 0.f; const float send = hi ? lov : hiv; o[c] = (hi ? hiv : lov) + __shfl_xor(send, 1 << BIT); }
}
__device__ __forceinline__ void route_row(const float (&acc)[36], const int lrow, const int row, const int lane, LAS float* lg, const float* __restrict__ br1, const float* __restrict__ br2, float* __restrict__ gw, LAS int* hist, LAS int* asgE, LAS int* asgP) {
    float r18[18], r9[9], r5[5], r3[3], r2[2], r1[1];
    rs_level<18, 18, 5>(acc, r18, lane); rs_level<9, 9, 4>(r18, r9, lane); rs_level<5, 4, 3>(r9, r5, lane); rs_level<3, 2, 2>(r5, r3, lane); rs_level<2, 1, 1>(r3, r2, lane); rs_level<1, 1, 0>(r2, r1, lane);
    const int idx3 = ((lane >> 1) & 1) * 2 + (lane & 1), idx5 = ((lane >> 2) & 1) * 3 + idx3;
    const bool valid = (idx3 <= 2) && (idx5 <= (((lane >> 3) & 1) ? 3 : 4));
    const int col = ((lane >> 5) & 1) * 18 + ((lane >> 4) & 1) * 9 + ((lane >> 3) & 1) * 5 + idx5;
    if (valid) lg[col] = r1[0];
    asm volatile("s_waitcnt lgkmcnt(0)" ::: "memory");
    float lc[4]; float mx = -1e30f; int gi = 0;
#pragma unroll
    for (int j = 0; j < 4; ++j) { lc[j] = lg[j] + br1[j]; const bool gt = lc[j] > mx; mx = gt ? lc[j] : mx; gi = gt ? j : gi; }
    float den = 0.f;
#pragma unroll
    for (int j = 0; j < 4; ++j) den += expf(lc[j] - mx);
    const float pg = 1.f / den;
    float v1 = -1e30f, v2 = -1e30f; int i1 = 0, i2 = 0;
#pragma unroll
    for (int j = 0; j < 8; ++j) { const float v = lg[4 + gi * 8 + j] + br2[gi * 8 + j];
        const bool b1 = v > v1, b2 = v > v2;
        v2 = b1 ? v1 : (b2 ? v : v2); i2 = b1 ? i1 : (b2 ? j : i2); v1 = b1 ? v : v1; i1 = b1 ? j : i1; }
    const float e2 = expf(v2 - v1), g1 = pg / (1.f + e2), g2 = pg * e2 / (1.f + e2);
    if (lane == 0) { const int ea = gi * 8 + i1, eb = gi * 8 + i2;
        gw[row * 2] = g1; gw[row * 2 + 1] = g2;
        asgE[lrow * 2] = ea; asgP[lrow * 2] = __hip_atomic_fetch_add(&hist[ea], 1, __ATOMIC_RELAXED, __HIP_MEMORY_SCOPE_WORKGROUP);
        asgE[lrow * 2 + 1] = eb; asgP[lrow * 2 + 1] = __hip_atomic_fetch_add(&hist[eb], 1, __ATOMIC_RELAXED, __HIP_MEMORY_SCOPE_WORKGROUP); }
}
template <int NY, bool ROUTER, bool LAST>
__device__ __forceinline__ void p_rows(LAS unsigned char* lds, const float* __restrict__ xin, const bf16_t* __restrict__ y0, const bf16_t* __restrict__ y1, const float* __restrict__ modg,
                                       const float* __restrict__ lnw, const float* __restrict__ lnb, float* __restrict__ xout, const float* __restrict__ modn, bf16_t* __restrict__ hout,
                                       const float* __restrict__ wr1, const float* __restrict__ br1, const float* __restrict__ wr2, const float* __restrict__ br2,
                                       float* __restrict__ gw, int* __restrict__ list, unsigned* __restrict__ cnt) {
    const int tid = threadIdx.x, lane = tid & 63, wave = __builtin_amdgcn_readfirstlane(tid >> 6);
    LAS float* wT = (LAS float*)lds;
    LAS int* hist = (LAS int*)(lds + 73728);
    LAS float* lgs = (LAS float*)(lds + 73728 + 1024);
    LAS int* basee = hist + 32;
    LAS int* asgE = hist + 64;
    LAS int* asgP = hist + 128;
    for (int rb = blockIdx.x; rb < 256; rb += gridDim.x) {
        if (ROUTER) { if (tid < 32) hist[tid] = 0; __syncthreads(); }
#pragma unroll 1
        for (int p = 0; p < 2; ++p) {
            const int lrow = wave * 4 + p * 2, row = rb * 32 + lrow;
            f32x4 h0[8], h1[8];
            row_ln<NY, LAST>(row, lane, xin, y0, y1, modg, lnw, lnb, xout, modn, hout, h0);
            row_ln<NY, LAST>(row + 1, lane, xin, y0, y1, modg, lnw, lnb, xout, modn, hout, h1);
            if (ROUTER) {
                float acc0[36], acc1[36];
#pragma unroll
                for (int c = 0; c < 36; ++c) { acc0[c] = 0.f; acc1[c] = 0.f; }
                router_round<0>(wT, tid, lane, wr1, wr2, h0, h1, acc0, acc1);
                router_round<1>(wT, tid, lane, wr1, wr2, h0, h1, acc0, acc1);
                router_round<2>(wT, tid, lane, wr1, wr2, h0, h1, acc0, acc1);
                router_round<3>(wT, tid, lane, wr1, wr2, h0, h1, acc0, acc1);
                route_row(acc0, lrow, row, lane, lgs + lrow * 40, br1, br2, gw, hist, asgE, asgP);
                route_row(acc1, lrow + 1, row + 1, lane, lgs + (lrow + 1) * 40, br1, br2, gw, hist, asgE, asgP);
            }
        }
        if (ROUTER) {
            __syncthreads();
            if (tid < 32) { const int n = hist[tid]; basee[tid] = n ? (int)__hip_atomic_fetch_add(cnt + tid, (unsigned)n, __ATOMIC_RELAXED, __HIP_MEMORY_SCOPE_AGENT) : 0; }
            __syncthreads();
            if (tid < 64) { const int e = asgE[tid]; list[e * 8192 + basee[e] + asgP[tid]] = (rb * 32 + (tid >> 1)) * 2 + (tid & 1); }
            __syncthreads();
        }
    }
}

__device__ __forceinline__ void moe_setup(LAS unsigned char* lds, const unsigned* cnt) {
    LAS int* tb = (LAS int*)(lds + LDS_TB);
    if (threadIdx.x == 0) { int s = 0; for (int e = 0; e < 32; ++e) { const int c = (int)__hip_atomic_load(cnt + e, __ATOMIC_RELAXED, __HIP_MEMORY_SCOPE_AGENT); tb[e] = s; tb[33 + e] = c; s += (c + 255) >> 8; } tb[32] = s; }
    __syncthreads();
}
struct MoeSched {
    static constexpr bool A_INV = false, B_INV = true;
    LAS const int* tb; const bf16_t* A; const bf16_t* Bt; const int* list; int K, ldb, NT, ntshift, nrowsB, G, c; bool gather, perm;
    __device__ bool next(int i, pg8::Unit& u) const {
        const int U = tb[32] << ntshift, rfull = U / G, rem = U - rfull * G;
        int L, mask = 15;
        if (i < rfull) L = i * G + c;
        else { if (i > rfull || rem == 0) return false;
            const int split = rem * 4 <= G ? 4 : (rem * 2 <= G ? 2 : 1), part = c / rem; if (part >= split) return false;
            L = rfull * G + c % rem; mask = split == 4 ? (1 << part) : (split == 2 ? (part ? 10 : 5) : 15); }
        const int tm = L >> ntshift;
        int e = 0;
#pragma unroll 1
        for (int k = 1; k < 32; ++k) e = (tb[k] <= tm) ? k : e;
        u.pm = tm; u.pn = L & (NT - 1); u.e = e; u.row0 = (tm - tb[e]) << 8; u.mask = mask; return true;
    }
    __device__ __forceinline__ const char* a_base(const pg8::Unit& u) const { return gather ? (const char*)A : (const char*)A + (size_t)u.pm * 256 * K * 2; }
    __device__ __forceinline__ const char* b_base(const pg8::Unit& u) const { return (const char*)Bt + ((size_t)u.e * nrowsB + (size_t)u.pn * 256) * K * 2; }
    __device__ __forceinline__ void a_offs(const pg8::Unit& u, const int (&R)[2], const int (&C)[2], unsigned (&o)[2][2]) const {
        const int cn = tb[33 + u.e];
#pragma unroll
        for (int h = 0; h < 2; ++h)
#pragma unroll
            for (int i = 0; i < 2; ++i) {
                if (gather) { const int row = u.row0 + h * 128 + R[i]; const int tok = row < cn ? (list[u.e * 8192 + row] >> 1) : 0; o[h][i] = (unsigned)(tok * K + C[i]) * 2u; }
                else o[h][i] = (unsigned)((h * 128 + R[i]) * K + C[i]) * 2u;
            }
    }
    __device__ __forceinline__ void b_offs(const pg8::Unit&, const int (&R)[2], const int (&C)[2], unsigned (&o)[2][2]) const {
#pragma unroll
        for (int h = 0; h < 2; ++h)
#pragma unroll
            for (int i = 0; i < 2; ++i) { const int Rb = perm ? ((R[i] & ~31) + pg8::perm32(R[i] & 31)) : R[i]; o[h][i] = (unsigned)((h * 128 + Rb) * K + C[i]) * 2u; }
    }
    __device__ __forceinline__ unsigned kstepA() const { return 128u; }
    __device__ __forceinline__ unsigned kstepB() const { return 128u; }
};
struct EpiAct {
    bf16_t* act;
    __device__ __forceinline__ void operator()(const f32x4 (&acc)[2][2][4][2], const pg8::Unit& u, int wr, int wc, int fr, int fq) const {
#pragma unroll
        for (int ai = 0; ai < 2; ++ai)
#pragma unroll
            for (int m = 0; m < 4; ++m) { const int arow = u.pm * 256 + ai * 128 + wr * 64 + m * 16 + fr;
#pragma unroll
                for (int bj = 0; bj < 2; ++bj) { if (!((u.mask >> (ai * 2 + bj)) & 1)) continue; const int j0 = (8 * u.pn + 4 * bj + wc) * 16 + 4 * fq; const f32x4 g = acc[ai][bj][m][0], up = acc[ai][bj][m][1]; f32x4 a;
#pragma unroll
                    for (int e = 0; e < 4; ++e) a[e] = g[e] / (1.f + __expf(-g[e])) * up[e];
                    *(u32x2*)(act + (size_t)arow * 512 + j0) = (u32x2){pack_bf16(a[0], a[1]), pack_bf16(a[2], a[3])}; } }
    }
};
struct EpiDown {
    LAS const int* tb; const int* list; const float* gw; bf16_t* yb;
    __device__ __forceinline__ void operator()(const f32x4 (&acc)[2][2][4][2], const pg8::Unit& u, int wr, int wc, int fr, int fq) const {
        const int cn = tb[33 + u.e], col0 = u.pn * 256 + wc * 32 + 8 * fq;
#pragma unroll
        for (int ai = 0; ai < 2; ++ai)
#pragma unroll
            for (int m = 0; m < 4; ++m) { const int row = u.row0 + ai * 128 + wr * 64 + m * 16 + fr;
                if (row < cn) { const int a = list[u.e * 8192 + row]; const float w = gw[a]; bf16_t* rowp = yb + (size_t)(a & 1) * T * D + (size_t)(a >> 1) * D + col0;
#pragma unroll
                    for (int bj = 0; bj < 2; ++bj) { if (!((u.mask >> (ai * 2 + bj)) & 1)) continue; const f32x4 v0 = acc[ai][bj][m][0] * w, v1 = acc[ai][bj][m][1] * w;
                        *(u32x4*)(rowp + bj * 128) = (u32x4){pack_bf16(v0[0], v0[1]), pack_bf16(v0[2], v0[3]), pack_bf16(v1[0], v1[1]), pack_bf16(v1[2], v1[3])}; } } }
    }
};

__device__ __forceinline__ void p0_dft(LAS unsigned char* lds, bf16_t* Dc, bf16_t* D12) {
    LAS float* tab = (LAS float*)lds;
    __syncthreads();
    for (int i = threadIdx.x; i < 4096; i += NTHR) { float s, c; sincospif((float)i / 2048.0f, &s, &c); tab[i] = c; }
    __syncthreads();
    for (size_t i = (size_t)blockIdx.x * NTHR + threadIdx.x; i < (size_t)1024 * 512 / 8; i += (size_t)gridDim.x * NTHR) {
        const size_t e = i * 8; const int m = (int)(e >> 9), c0 = (int)(e & 511), cp = m >> 1, part = m & 1; unsigned w[4];
#pragma unroll
        for (int j = 0; j < 8; j += 2) { const int i0 = (((c0 + j) * cp) & 511) * 8, i1 = (((c0 + j + 1) * cp) & 511) * 8;
            const float a = part ? tab[(i0 - 1024) & 4095] : tab[i0], b = part ? tab[(i1 - 1024) & 4095] : tab[i1]; w[j >> 1] = pack_bf16(a, b); }
        *(u32x4*)(Dc + e) = (u32x4){w[0], w[1], w[2], w[3]};
    }
    for (size_t i = (size_t)blockIdx.x * NTHR + threadIdx.x; i < (size_t)65 * 256 * 128; i += (size_t)gridDim.x * NTHR) {
        const int blk = (int)(i >> 15), r = (int)(i >> 7) & 255, k = (int)i & 127, half = k >> 6, kk = k & 63; float v = 0.f;
        if (blk == 0) { if (r < 128) { const int idx = ((r & 63) * kk * 64) & 4095; const float cs = tab[idx], sn = tab[(idx - 1024) & 4095]; v = r < 64 ? (half ? -sn : cs) : (half ? -cs : -sn); } }
        else if (r < 64) { const int idx = (kk * (64 * r + (blk - 1))) & 4095; v = half ? tab[(idx - 1024) & 4095] : tab[idx]; }
        D12[i] = (bf16_t)(pack_bf16(v, v) & 0xffffu);
    }
    __syncthreads();
}
struct ChanSched {
    static constexpr bool A_INV = true, B_INV = false;
    const bf16_t* Dc; const bf16_t* u; int G, c;
    __device__ bool next(int i, pg8::Unit& un) const { const int L = i * G + c; if (L >= 512) return false; un.e = L >> 6; const int rem = L & 63; un.pm = rem & 3; un.pn = rem >> 2; un.row0 = 0; un.mask = 15; return true; }
    __device__ __forceinline__ const char* a_base(const pg8::Unit& un) const { return (const char*)Dc + (size_t)un.pm * 256 * 512 * 2; }
    __device__ __forceinline__ const char* b_base(const pg8::Unit& un) const { return (const char*)u + ((size_t)(un.e >> 2) * 4096 * 2048 + (un.e & 3) * 512) * 2; }
    __device__ __forceinline__ void a_offs(const pg8::Unit&, const int (&R)[2], const int (&C)[2], unsigned (&o)[2][2]) const {
#pragma unroll
        for (int h = 0; h < 2; ++h)
#pragma unroll
            for (int i = 0; i < 2; ++i) o[h][i] = (unsigned)((h * 128 + R[i]) * 512 + C[i]) * 2u; }
    __device__ __forceinline__ void b_offs(const pg8::Unit& un, const int (&R)[2], const int (&C)[2], unsigned (&o)[2][2]) const {
#pragma unroll
        for (int h = 0; h < 2; ++h)
#pragma unroll
            for (int i = 0; i < 2; ++i) { const int n = un.pn * 256 + h * 128 + (R[i] & ~31) + pg8::perm32(R[i] & 31), s = (n >> 6) + 64 * (n & 63); o[h][i] = (unsigned)(s * 2048 + C[i]) * 2u; } }
    __device__ __forceinline__ unsigned kstepA() const { return 128u; }
    __device__ __forceinline__ unsigned kstepB() const { return 128u; }
};
struct Fft1Sched {
    static constexpr bool A_INV = true, B_INV = false;
    const bf16_t* D1; const bf16_t* ABt; int G, c;
    __device__ bool next(int i, pg8::Unit& un) const { const int L = i * G + c; if (L >= 1024) return false; un.pm = 0; un.pn = L; un.e = 0; un.row0 = 0; un.mask = 15; return true; }
    __device__ __forceinline__ const char* a_base(const pg8::Unit&) const { return (const char*)D1; }
    __device__ __forceinline__ const char* b_base(const pg8::Unit&) const { return (const char*)ABt; }
    __device__ __forceinline__ void a_offs(const pg8::Unit&, const int (&R)[2], const int (&C)[2], unsigned (&o)[2][2]) const {
#pragma unroll
        for (int h = 0; h < 2; ++h)
#pragma unroll
            for (int i = 0; i < 2; ++i) o[h][i] = (unsigned)((h * 128 + R[i]) * 128 + C[i]) * 2u; }
    __device__ __forceinline__ void b_offs(const pg8::Unit& un, const int (&R)[2], const int (&C)[2], unsigned (&o)[2][2]) const {
#pragma unroll
        for (int h = 0; h < 2; ++h)
#pragma unroll
            for (int i = 0; i < 2; ++i) { int rr = R[i], cc = C[i]; asm volatile("" : "+v"(rr), "+v"(cc));
                const int n = un.pn * 256 + h * 128 + (rr & ~31) + pg8::perm32(rr & 31); o[h][i] = (unsigned)((n >> 6) * 8192 + (n & 63) * 64 + cc) * 2u; } }
    __device__ __forceinline__ unsigned kstepA() const { return 128u; }
    __device__ __forceinline__ unsigned kstepB() const { return 8192u; }
};
struct EpiFft1 {
    bf16_t* T2;
    __device__ __forceinline__ void operator()(const f32x4 (&acc)[2][2][4][2], const pg8::Unit& u, int wr, int wc, int fr, int fq) const {
#pragma unroll
        for (int m = 0; m < 4; ++m) { const int k2 = 16 * m + fr;
#pragma unroll
            for (int bj = 0; bj < 2; ++bj) { const int n0 = u.pn * 256 + bj * 128 + wc * 32 + 8 * fq, colg = n0 >> 6, s10 = n0 & 63;
                const f32x4 v0 = acc[0][bj][m][0], v1 = acc[0][bj][m][1];
                *(u32x4*)(T2 + ((size_t)(colg * 64 + k2) * 2 + wr) * 64 + s10) = (u32x4){pack_bf16(v0[0], v0[1]), pack_bf16(v0[2], v0[3]), pack_bf16(v1[0], v1[1]), pack_bf16(v1[2], v1[3])}; } }
    }
};
struct Fft2Sched {
    static constexpr bool A_INV = true, B_INV = false;
    const bf16_t* D2; const bf16_t* T2; int G, c;
    __device__ bool next(int i, pg8::Unit& un) const { const int L = i * G + c; if (L >= 1024) return false; un.pm = 0; un.pn = L; un.e = 0; un.row0 = 0; un.mask = 15; return true; }
    __device__ __forceinline__ const char* a_base(const pg8::Unit& un) const { return (const char*)D2 + (size_t)((un.pn >> 3) & 63) * 256 * 128 * 2; }
    __device__ __forceinline__ const char* b_base(const pg8::Unit&) const { return (const char*)T2; }
    __device__ __forceinline__ void a_offs(const pg8::Unit&, const int (&R)[2], const int (&C)[2], unsigned (&o)[2][2]) const {
#pragma unroll
        for (int h = 0; h < 2; ++h)
#pragma unroll
            for (int i = 0; i < 2; ++i) o[h][i] = (unsigned)((h * 128 + R[i]) * 128 + C[i]) * 2u; }
    __device__ __forceinline__ void b_offs(const pg8::Unit& un, const int (&R)[2], const int (&C)[2], unsigned (&o)[2][2]) const {
#pragma unroll
        for (int h = 0; h < 2; ++h)
#pragma unroll
            for (int i = 0; i < 2; ++i) { const int n = un.pn * 256 + h * 128 + (R[i] & ~31) + pg8::perm32(R[i] & 31), b = n >> 17, k2 = (n >> 11) & 63, col = n & 2047;
                o[h][i] = (unsigned)(((b * 2048 + col) * 64 + k2) * 128 + C[i]) * 2u; } }
    __device__ __forceinline__ unsigned kstepA() const { return 128u; }
    __device__ __forceinline__ unsigned kstepB() const { return 128u; }
};
struct EpiFft2 {
    bf16_t* Y; float scale;
    __device__ __forceinline__ void operator()(const f32x4 (&acc)[2][2][4][2], const pg8::Unit& u, int wr, int wc, int fr, int fq) const {
        if (wr != 0) return;
#pragma unroll
        for (int m = 0; m < 4; ++m) { const int k1 = 16 * m + fr;
#pragma unroll
            for (int bj = 0; bj < 2; ++bj) { const int n0 = u.pn * 256 + bj * 128 + wc * 32 + 8 * fq, b = n0 >> 17, k2 = (n0 >> 11) & 63, col = n0 & 2047;
                const f32x4 v0 = acc[0][bj][m][0] * scale, v1 = acc[0][bj][m][1] * scale;
                *(u32x4*)(Y + (size_t)(b * 4096 + 64 * k1 + k2) * 2048 + col) = (u32x4){pack_bf16(v0[0], v0[1]), pack_bf16(v0[2], v0[3]), pack_bf16(v1[0], v1[1]), pack_bf16(v1[2], v1[3])}; } }
    }
};

constexpr int NPHASE = 19;
#ifndef REP_MASK
#define REP_MASK 0
#endif
#define PH_BEGIN(k) _Pragma("unroll") for (int rp = 0; rp < 1 + ((REP_MASK >> (k)) & 1); ++rp) { if (rp) xcd_barrier(bar);
__global__ void __launch_bounds__(NTHR, 2) mk_fwd(Args a) {
    extern __shared__ __attribute__((aligned(16))) unsigned char lds_raw[];
    LAS unsigned char* lds = (LAS unsigned char*)lds_raw;
    unsigned char* ws = a.ws;
    volatile LAS unsigned* misc = (volatile LAS unsigned*)(lds + LDS_MISC);
    if (threadIdx.x < 4) misc[threadIdx.x] = 0u;
    __syncthreads();
    const int lo = a.ph_lo, hi = a.ph_hi;
    XcdBarrier bar; bar.bar = (unsigned*)(ws + WS_CTL) + CW_BAR; bar.x = 0; bar.st = misc;
    if (hi - lo > 1) bar = xcd_barrier_post((unsigned*)(ws + WS_CTL) + CW_BAR, misc);
#define IN(k) (lo <= (k) && (k) < hi)
#define SEAM(k) do { if (IN(k) && IN((k) + 1)) xcd_barrier(bar); } while (0)
    float* mod = (float*)(ws + WS_MOD); float* rot = (float*)(ws + WS_ROT);
    bf16_t* hbuf = (bf16_t*)(ws + WS_H); bf16_t* ybr = (bf16_t*)(ws + WS_Y); bf16_t* yb = (bf16_t*)(ws + WS_YB); bf16_t* act = (bf16_t*)(ws + WS_ACT);
    float* x1 = (float*)(ws + WS_X1); float* x2 = (float*)(ws + WS_X2); float* gw = (float*)(ws + WS_GW); int* list = (int*)(ws + WS_LIST);
    unsigned* cnt = (unsigned*)(ws + WS_CTL) + CW_CNT;
    LAS const int* tb = (LAS const int*)(lds + LDS_TB);
    const float* x = a.in[0]; const float* ln_g = a.in[9]; const float* ln_b = a.in[10];
    const int G = gridDim.x, cid = blockIdx.x;
    const int vcid = (G & 7) ? cid : (cid & 7) * (G >> 3) + (cid >> 3);

    if (IN(0)) { PH_BEGIN(0)  p0_adaln(a, lds, mod); p0_tables(a, rot); p0_dft(lds, (bf16_t*)(ws + WS_DC), (bf16_t*)(ws + WS_D12)); p0_transposes(a, lds);  } }
    SEAM(0);
    if (IN(1)) { PH_BEGIN(1)  p_modulate(x, mod, hbuf);  } }
    SEAM(1);
    if (IN(2)) { PH_BEGIN(2)  QkvSched S{ws, G, cid};
        EpiQKV E{(bf16_t*)(ws + WS_QF), (bf16_t*)(ws + WS_KF), (bf16_t*)(ws + WS_VF), rot};
        pg8::gemm_phase<EpiQKV, QkvSched>(lds, D, S, E); } }
    SEAM(2);
    if (IN(3)) { PH_BEGIN(3)  p_attention(lds, (const bf16_t*)(ws + WS_QF), (const bf16_t*)(ws + WS_KF), (const bf16_t*)(ws + WS_VF), (bf16_t*)(ws + WS_O));  } }
    SEAM(3);
    if (IN(5)) { PH_BEGIN(5)  pg8::PlainSched S; S.init((const bf16_t*)(ws + WS_O), (const bf16_t*)(ws + WS_WO), T, D, D, G, cid); EpiBf16 E{ybr, D, 1.f, 0};
        pg8::gemm_phase<EpiBf16, pg8::PlainSched>(lds, D, S, E);  } }
    SEAM(5);
    if (IN(6)) { PH_BEGIN(6)  p_rows<1, true, false>(lds, x, ybr, ybr, mod, ln_g, ln_b, x1, mod + 1 * 12288, hbuf, a.in[11], a.in[12], a.in[13], a.in[14], gw, list, cnt);  } }
    SEAM(6);
    if (IN(7)) { PH_BEGIN(7)  moe_setup(lds, cnt);
        MoeSched S{tb, hbuf, (const bf16_t*)(ws + WS_WGU), list, D, D, 4, 2, 1024, G, vcid, true, false}; EpiAct E{act};
        pg8::gemm_phase<EpiAct, MoeSched, false, true>(lds, D, S, E);  } }
    SEAM(7);
    if (IN(8)) { PH_BEGIN(8)  moe_setup(lds, cnt);
        MoeSched S{tb, act, (const bf16_t*)(ws + WS_WD), list, ED, ED, 8, 3, 2048, G, vcid, false, true}; EpiDown E{tb, list, gw, yb};
        pg8::gemm_phase<EpiDown, MoeSched, false, true>(lds, ED, S, E);  } }
    SEAM(8);
    if (IN(9)) { PH_BEGIN(9)  p_rows<2, false, false>(lds, x1, yb, yb + (size_t)T * D, mod + 1 * 12288, ln_g + D, ln_b + D, x2, mod + 2 * 12288, hbuf, nullptr, nullptr, nullptr, nullptr, nullptr, nullptr, nullptr);  } }
    SEAM(9);
    if (IN(10)) { PH_BEGIN(10)  pg8::PlainSched S; S.init(hbuf, (const bf16_t*)(ws + WS_WIN), T, D, D, G, cid); EpiBf16 E{(bf16_t*)(ws + WS_U), D, 1.f, 0};
        pg8::gemm_phase<EpiBf16, pg8::PlainSched>(lds, D, S, E);  } }
    SEAM(10);
    if (IN(11)) { PH_BEGIN(11)  ChanSched S{(const bf16_t*)(ws + WS_DC), (const bf16_t*)(ws + WS_U), G, vcid}; EpiBf16 E{(bf16_t*)(ws + WS_ABT), 4096, 1.f, 1};
        pg8::gemm_phase<EpiBf16, ChanSched>(lds, 512, S, E);  } }
    SEAM(11);
    if (IN(12)) { PH_BEGIN(12)  Fft1Sched S{(const bf16_t*)(ws + WS_D12), (const bf16_t*)(ws + WS_ABT), G, cid}; EpiFft1 E{(bf16_t*)(ws + WS_T2)};
        pg8::gemm_phase<EpiFft1, Fft1Sched, true>(lds, 128, S, E); } }
    SEAM(12);
    if (IN(13)) { PH_BEGIN(13)  Fft2Sched S{(const bf16_t*)(ws + WS_D12) + 256 * 128, (const bf16_t*)(ws + WS_T2), G, cid}; EpiFft2 E{(bf16_t*)(ws + WS_YF), 6.9053396600248786e-4f};
        pg8::gemm_phase<EpiFft2, Fft2Sched, true>(lds, 128, S, E); } }
    SEAM(13);
    if (IN(14)) { PH_BEGIN(14)  pg8::PlainSched S; S.init((const bf16_t*)(ws + WS_YF), (const bf16_t*)(ws + WS_WOUT), T, D, D, G, cid); EpiBf16 E{ybr, D, 1.f, 0};
        pg8::gemm_phase<EpiBf16, pg8::PlainSched>(lds, D, S, E);  } }
    SEAM(14);
    if (IN(15)) { PH_BEGIN(15)  p_rows<1, true, false>(lds, x2, ybr, ybr, mod + 2 * 12288, ln_g + 2 * D, ln_b + 2 * D, x1, mod + 3 * 12288, hbuf, a.in[11] + D * 4, a.in[12] + 4, a.in[13] + D * 32, a.in[14] + 32, gw, list, cnt + 32);  } }
    SEAM(15);
    if (IN(16)) { PH_BEGIN(16)  moe_setup(lds, cnt + 32);
        MoeSched S{tb, hbuf, (const bf16_t*)(ws + WS_WGU) + (size_t)32 * 1024 * 2048, list, D, D, 4, 2, 1024, G, vcid, true, false}; EpiAct E{act};
        pg8::gemm_phase<EpiAct, MoeSched, false, true>(lds, D, S, E);  } }
    SEAM(16);
    if (IN(17)) { PH_BEGIN(17)  moe_setup(lds, cnt + 32);
        MoeSched S{tb, act, (const bf16_t*)(ws + WS_WD) + (size_t)32 * 2048 * 512, list, ED, ED, 8, 3, 2048, G, vcid, false, true}; EpiDown E{tb, list, gw, yb};
        pg8::gemm_phase<EpiDown, MoeSched, false, true>(lds, ED, S, E);  } }
    SEAM(17);
    if (IN(18)) { PH_BEGIN(18) p_rows<2, false, true>(lds, x1, yb, yb + (size_t)T * D, mod + 3 * 12288, ln_g + 3 * D, ln_b + 3 * D, a.out, nullptr, nullptr, nullptr, nullptr, nullptr, nullptr, nullptr, nullptr, nullptr); } }
#undef IN
#undef SEAM
}

}

extern "C" void kernel_launch(void* const* d_in, const int* in_sizes, int n_in, void* d_out, int out_size, void* d_ws, size_t ws_size, hipStream_t stream) {
    (void)in_sizes; (void)n_in; (void)out_size; (void)ws_size;
    static bool attr = false;
    if (!attr) { (void)hipFuncSetAttribute((const void*)mk_fwd, hipFuncAttributeMaxDynamicSharedMemorySize, LDS_BYTES); attr = true; }
    (void)hipMemsetAsync((char*)d_ws + WS_CTL, 0, CTL_BYTES, stream);
    Args a{};
    for (int i = 0; i < 18; ++i) a.in[i] = (const float*)d_in[i];
    a.out = (float*)d_out; a.ws = (unsigned char*)d_ws;
    a.ph_lo = 0; a.ph_hi = NPHASE; a.rep = 0;
    hipLaunchKernelGGL(mk_fwd, dim3(256), dim3(NTHR), LDS_BYTES, stream, a);
}
```

```cpp
#include <hip/hip_runtime.h>
#include <stdint.h>

namespace {
constexpr int D = 2048, NB = 2, SEQ = 4096, T = NB * SEQ, NQKV = 18432, NE = 32, ED = 512;
constexpr float ALPHA = 1.41421356237309515f;
constexpr float LN_EPS = 1e-5f;

#define LAS __attribute__((address_space(3)))
typedef unsigned short bf16_t;
typedef short bf16x8 __attribute__((ext_vector_type(8)));
typedef float f32x4 __attribute__((ext_vector_type(4)));
typedef float f32x16 __attribute__((ext_vector_type(16)));
typedef unsigned u32x4 __attribute__((ext_vector_type(4)));
typedef unsigned u32x2 __attribute__((ext_vector_type(2)));

constexpr float QSCALE = 0.08838834764831845f * 1.4426950408889634f;
constexpr int NTHR = 512;
constexpr int LDS_BYTES = 147456;
constexpr int LDS_MISC = 143360;

constexpr size_t MB = 1024 * 1024;
constexpr size_t WS_CTL = 0;
constexpr size_t CTL_BYTES = 32768;
constexpr size_t WS_MOD = WS_CTL + CTL_BYTES;
constexpr size_t WS_ROT = WS_MOD + 196608;
constexpr size_t WS_LSE = WS_ROT + 1 * MB;
constexpr size_t WS_EID = WS_LSE + 1536 * 1024;
constexpr size_t WS_GW = WS_EID + 65536;
constexpr size_t WS_LIST = WS_GW + 65536;
constexpr size_t WS_DC = WS_LIST + 1 * MB;
constexpr size_t WS_WQKV = WS_DC + 1 * MB;
constexpr size_t WS_WO = WS_WQKV + (size_t)18432 * 2048 * 2;
constexpr size_t WS_WIN = WS_WO + 8 * MB;
constexpr size_t WS_WOUT = WS_WIN + 8 * MB;
constexpr size_t WS_WGU = WS_WOUT + 8 * MB;
constexpr size_t WS_WD = WS_WGU + 256 * MB;
constexpr size_t WS_H = WS_WD + 128 * MB;
constexpr size_t WS_O = WS_H + 32 * MB;
constexpr size_t WS_QF = WS_O + 32 * MB;
constexpr size_t WS_KF = WS_QF + 96 * MB;
constexpr size_t WS_VF = WS_KF + 96 * MB;
constexpr size_t WS_FAST_END = WS_VF + 192 * MB;

constexpr int CW_BAR = 0;
constexpr int CW_CNT = 4096;

__device__ __forceinline__ unsigned pack_bf16(float lo, float hi) { unsigned r; asm("v_cvt_pk_bf16_f32 %0, %1, %2" : "=v"(r) : "v"(lo), "v"(hi)); return r; }
__device__ __forceinline__ float bf16_to_f32(bf16_t v) { return __uint_as_float(((unsigned)v) << 16); }
__device__ __forceinline__ int pi32(int x) { return (x & ~12) | ((x & 4) << 1) | ((x & 8) >> 1); }

#define XB_TMO      128
#define XB_XCNT(j)  (256  + 64 * (j))
#define XB_XSUB(j)  (1280 + 64 * (j))
#define XB_XGEN(j)  (2304 + 64 * (j))
#define XB_TOP      3328
#define XB_TOPGEN   3392
#define XCD_BAR_WORDS 3456
#define XB_SPIN_CAP (1u << 18)
__device__ __forceinline__ unsigned xb_ld(unsigned* p)              { return __hip_atomic_load(p, __ATOMIC_RELAXED, __HIP_MEMORY_SCOPE_AGENT); }
__device__ __forceinline__ unsigned xb_add(unsigned* p, unsigned v) { return __hip_atomic_fetch_add(p, v, __ATOMIC_RELAXED, __HIP_MEMORY_SCOPE_AGENT); }
__device__ __forceinline__ unsigned xb_xcc_id() { return (unsigned)__builtin_amdgcn_s_getreg((3 << 11) | 20) & 0xFu; }
#define XB_SPIN(cond, bar) do { unsigned _sp = 0; while (cond) { __builtin_amdgcn_s_sleep(1); \
    if ((++_sp & 255u) == 0u) { if (xb_ld(&(bar)[XB_TMO])) break; if (_sp > XB_SPIN_CAP) { atomicAdd(&(bar)[XB_TMO], 1u); break; } } } } while (0)
struct XcdBarrier { unsigned* bar; unsigned x; volatile LAS unsigned* st; };
__device__ __forceinline__ XcdBarrier xcd_barrier_post(unsigned* bar, volatile LAS unsigned* st) {
    XcdBarrier b; b.bar = bar; b.x = xb_xcc_id(); b.st = st;
    if (threadIdx.x == 0) (void)xb_add(&bar[XB_XCNT(b.x)], 1u);
    return b;
}
__device__ __forceinline__ void xcd_barrier_complete(unsigned* bar, unsigned x, unsigned& nloc, unsigned& nx) {
    const unsigned G = gridDim.x * gridDim.y * gridDim.z;
    unsigned sum, cnt, mine, sp = 0u;
    for (;;) {
        sum = 0u; cnt = 0u; mine = 0u;
#pragma unroll
        for (unsigned j = 0; j < 16; ++j) { const unsigned c = xb_ld(&bar[XB_XCNT(j)]); sum += c; cnt += (c > 0u) ? 1u : 0u; mine = (j == x) ? c : mine; }
        if (sum == G) break;
        __builtin_amdgcn_s_sleep(1);
        if ((++sp & 255u) == 0u) { if (xb_ld(&bar[XB_TMO])) break; if (sp > XB_SPIN_CAP) { atomicAdd(&bar[XB_TMO], 1u); break; } }
    }
    nloc = mine > 0u ? mine : 1u; nx = cnt > 0u ? cnt : 1u;
}
__device__ __forceinline__ void xcd_barrier(const XcdBarrier& b) {
    asm volatile("s_waitcnt vmcnt(0)" ::: "memory");
    __syncthreads();
    if (threadIdx.x == 0) {
        unsigned* bar = b.bar;
        __builtin_amdgcn_s_waitcnt(0);
        unsigned nloc = b.st[0], nx = b.st[1];
        if (nloc == 0u) { xcd_barrier_complete(bar, b.x, nloc, nx); b.st[0] = nloc; b.st[1] = nx; }
        const unsigned old = xb_add(&bar[XB_XSUB(b.x)], 1u);
        const unsigned gen = old / nloc;
        if (old + 1u == (gen + 1u) * nloc) {
            __builtin_amdgcn_fence(__ATOMIC_RELEASE, "agent");
            asm volatile("s_waitcnt vmcnt(0)" ::: "memory");
            const unsigned og = xb_add(&bar[XB_TOP], 1u);
            const unsigned tg = og / nx;
            if (og + 1u == (tg + 1u) * nx) xb_add(&bar[XB_TOPGEN], 1u);
            else XB_SPIN(xb_ld(&bar[XB_TOPGEN]) == tg, bar);
            __builtin_amdgcn_fence(__ATOMIC_ACQUIRE, "agent");
            xb_add(&bar[XB_XGEN(b.x)], 1u);
            asm volatile("s_waitcnt vmcnt(0)" ::: "memory");
        } else {
            XB_SPIN(xb_ld(&bar[XB_XGEN(b.x)]) == gen, bar);
            __builtin_amdgcn_fence(__ATOMIC_ACQUIRE, "agent");
            asm volatile("s_waitcnt vmcnt(0)" ::: "memory");
        }
    }
    __syncthreads();
}

namespace pg8 {
constexpr int BM = 256, BK = 64, HALF = 128, HTB = HALF * BK * 2, STAGE_BYTES = 8 * HTB, NXCD = 8, WGM = 8;
__host__ __device__ __forceinline__ int lds_byte(int r, int c) { const int st = (r >> 4) * 2 + (c >> 5), rr = r & 15, cc = c & 31, ob = rr * 64 + cc * 2; return st * 1024 + (ob ^ (((ob >> 9) & 1) << 5)); }
__host__ __device__ __forceinline__ void stage_rc(int b, int& R, int& C) { const int st = b / 1024, sb = b % 1024, swz = sb ^ (((sb >> 9) & 1) << 5); R = (st >> 1) * 16 + swz / 64; C = (st & 1) * 32 + (swz % 64) / 2; }
__host__ __device__ __forceinline__ int perm32(int rho) { const int n = rho >> 4, i = rho & 15; return 8 * (i >> 2) + 4 * n + (i & 3); }

struct Unit { int pm, pn, e, row0, mask; };

struct PlainSched {
    static constexpr bool A_INV = true, B_INV = true;
    const bf16_t* A; const bf16_t* Bt; int K, ldb; int nM, nN, nwg, G, c;
    __device__ void init(const bf16_t* A_, const bf16_t* Bt_, int M, int N, int K_, int G_, int c_) { A = A_; Bt = Bt_; K = K_; ldb = K_; nM = M / BM; nN = N / BM; nwg = nM * nN; G = G_; c = c_; }
    __device__ bool next(int i, Unit& u) const {
        const long L = (long)i * G + c; if (L >= nwg) return false;
        int wgid = (int)L; { const int q = nwg / NXCD, r = nwg % NXCD, xcd = wgid % NXCD, off = wgid / NXCD; wgid = (xcd < r ? xcd * (q + 1) : r * (q + 1) + (xcd - r) * q) + off; }
        const int nig = WGM * nN, gid = wgid / nig, fm = gid * WGM, gsz = (nM - fm) < WGM ? (nM - fm) : WGM;
        u.pm = fm + ((wgid % nig) % gsz); u.pn = (wgid % nig) / gsz; u.e = 0; u.row0 = 0; u.mask = 15; return true;
    }
    __device__ __forceinline__ const char* a_base(const Unit& u) const { return (const char*)A + (size_t)u.pm * BM * K * 2; }
    __device__ __forceinline__ const char* b_base(const Unit& u) const { return (const char*)Bt + (size_t)u.pn * BM * K * 2; }
    __device__ __forceinline__ void a_offs(const Unit&, const int (&R)[2], const int (&C)[2], unsigned (&o)[2][2]) const {
#pragma unroll
        for (int h = 0; h < 2; ++h)
#pragma unroll
            for (int i = 0; i < 2; ++i) o[h][i] = (unsigned)((h * HALF + R[i]) * K + C[i]) * 2u;
    }
    __device__ __forceinline__ void b_offs(const Unit&, const int (&R)[2], const int (&C)[2], unsigned (&o)[2][2]) const {
#pragma unroll
        for (int h = 0; h < 2; ++h)
#pragma unroll
            for (int i = 0; i < 2; ++i) o[h][i] = (unsigned)((h * HALF + (R[i] & ~31) + perm32(R[i] & 31)) * ldb + C[i]) * 2u;
    }
    __device__ __forceinline__ unsigned kstepA() const { return 128u; }
    __device__ __forceinline__ unsigned kstepB() const { return 128u; }
};

template <class Epi, class Sched, bool ONE_TRIP = false, bool MASKED = false>
__device__ __forceinline__ void gemm_phase(LAS unsigned char* lds, const int K, const Sched& S, const Epi& E) {
    int tid_ = threadIdx.x; asm volatile("" : "+v"(tid_));
    const int tid = tid_, wid = __builtin_amdgcn_readfirstlane(tid >> 6), lane = tid & 63, wr = wid >> 2, wc = wid & 3, fr = lane & 15, fq = lane >> 4;
    const int nt = K / BK;
    int sR[2], sC[2];
#pragma unroll
    for (int i = 0; i < 2; ++i) stage_rc(tid * 16 + i * 8192, sR[i], sC[i]);
    const size_t kA = S.kstepA(), kB = S.kstepB();
    const unsigned ldsw = (unsigned)wid * 1024u;
    const int aoff = lds_byte(wr * 64 + fr, fq * 8), boff = lds_byte(wc * 32 + fr, fq * 8);
#define PG8_SA(b, h) (((b) * 2 + (h)) * HTB)
#define PG8_SB(b, h) ((4 + (b) * 2 + (h)) * HTB)
#define PG8_GLDS(src, dstoff) __builtin_amdgcn_global_load_lds((const unsigned*)(src), (LAS unsigned*)(lds + (dstoff)), 16, 0, 0)
#define PG8_STAGE(bufoff, gbase, o0, o1) do { PG8_GLDS((const char*)(gbase) + (o0), (bufoff) + ldsw); PG8_GLDS((const char*)(gbase) + (o1), (bufoff) + ldsw + 8192); } while (0)
#define PG8_LDA(dst, b, h) do { _Pragma("unroll") for (int m = 0; m < 4; ++m) _Pragma("unroll") for (int k = 0; k < 2; ++k) dst[m][k] = *(const LAS bf16x8*)(lds + PG8_SA(b, h) + aoff + m * 2048 + k * 1024); } while (0)
#define PG8_LDB(dst, b, h) do { _Pragma("unroll") for (int n = 0; n < 2; ++n) _Pragma("unroll") for (int k = 0; k < 2; ++k) dst[n][k] = *(const LAS bf16x8*)(lds + PG8_SB(b, h) + boff + n * 2048 + k * 1024); } while (0)
#define PG8_MMA(ai, bj, At, Bt) do { __builtin_amdgcn_s_setprio(1); _Pragma("unroll") for (int m = 0; m < 4; ++m) _Pragma("unroll") for (int n = 0; n < 2; ++n) _Pragma("unroll") for (int k = 0; k < 2; ++k) \
        acc[ai][bj][m][n] = __builtin_amdgcn_mfma_f32_16x16x32_bf16(Bt[n][k], At[m][k], acc[ai][bj][m][n], 0, 0, 0); __builtin_amdgcn_s_setprio(0); } while (0)
#define PG8_MMAQ(ai, bj, At, Bt) do { if (!MASKED || ((cur.mask >> ((ai) * 2 + (bj))) & 1)) PG8_MMA(ai, bj, At, Bt); } while (0)
#define PG8_WAIT_V(n) asm volatile("s_waitcnt vmcnt(" #n ")" ::: "memory")
#define PG8_WAIT_L(n) asm volatile("s_waitcnt lgkmcnt(" #n ")" ::: "memory")
#define PG8_BAR __builtin_amdgcn_s_barrier()
#define PG8_SCHED __builtin_amdgcn_sched_barrier(0)
    Unit cur, nxt; int ui = 0;
    if (!S.next(0, cur)) return;
    f32x4 acc[2][2][4][2];
#pragma unroll
    for (int a = 0; a < 2; ++a)
#pragma unroll
        for (int b = 0; b < 2; ++b)
#pragma unroll
            for (int m = 0; m < 4; ++m)
#pragma unroll
                for (int n = 0; n < 2; ++n) acc[a][b][m][n] = (f32x4){0.f, 0.f, 0.f, 0.f};
    bf16x8 At[4][2], B0[2][2], B1[2][2];
    unsigned vc[2][2], wc_[2][2];
    S.a_offs(cur, sR, sC, vc); S.b_offs(cur, sR, sC, wc_);
    const char* cA = S.a_base(cur); const char* cB = S.b_base(cur);
    PG8_STAGE(PG8_SB(0, 0), cB, wc_[0][0], wc_[0][1]); PG8_STAGE(PG8_SB(0, 1), cB, wc_[1][0], wc_[1][1]); PG8_STAGE(PG8_SA(0, 0), cA, vc[0][0], vc[0][1]); PG8_STAGE(PG8_SA(0, 1), cA, vc[1][0], vc[1][1]);
    if (wr == 1) PG8_BAR;
    PG8_WAIT_V(2); PG8_BAR;
    PG8_STAGE(PG8_SB(1, 0), cB + kB, wc_[0][0], wc_[0][1]); PG8_STAGE(PG8_SA(1, 0), cA + kA, vc[0][0], vc[0][1]); PG8_STAGE(PG8_SB(1, 1), cB + kB, wc_[1][0], wc_[1][1]);
    PG8_WAIT_V(6); PG8_BAR;
#define PG8_TRIP(a1, a2, a3, b2, b3, C10, C11, N00, N01, N10, N11, M00, M01, M10, M11) do { \
              \
            PG8_LDB(B0, 0, 0); PG8_LDB(B1, 0, 1); PG8_SCHED; PG8_LDA(At, 0, 0); PG8_STAGE(PG8_SA(1, 1), a1, C10, C11); \
            PG8_WAIT_V(8); PG8_WAIT_L(0); PG8_BAR; PG8_MMAQ(0, 0, At, B0); PG8_MMAQ(0, 1, At, B1); PG8_BAR; PG8_SCHED; \
              \
            PG8_LDA(At, 0, 1); PG8_STAGE(PG8_SB(0, 0), b2, M00, M01); PG8_STAGE(PG8_SB(0, 1), b2, M10, M11); PG8_STAGE(PG8_SA(0, 0), a2, N00, N01); \
            PG8_WAIT_V(8); PG8_WAIT_L(0); PG8_BAR; PG8_MMAQ(1, 0, At, B0); PG8_MMAQ(1, 1, At, B1); PG8_BAR; PG8_SCHED; \
              \
            PG8_LDB(B0, 1, 0); PG8_LDB(B1, 1, 1); PG8_SCHED; PG8_LDA(At, 1, 0); PG8_STAGE(PG8_SA(0, 1), a2, N10, N11); \
            PG8_WAIT_V(8); PG8_WAIT_L(0); PG8_BAR; PG8_MMAQ(0, 0, At, B0); PG8_MMAQ(0, 1, At, B1); PG8_BAR; PG8_SCHED; \
              \
            PG8_LDA(At, 1, 1); PG8_STAGE(PG8_SB(1, 0), b3, M00, M01); PG8_STAGE(PG8_SB(1, 1), b3, M10, M11); PG8_STAGE(PG8_SA(1, 0), a3, N00, N01); \
            PG8_WAIT_V(8); PG8_WAIT_L(0); PG8_BAR; PG8_MMAQ(1, 0, At, B0); PG8_MMAQ(1, 1, At, B1); PG8_BAR; PG8_SCHED; } while (0)
    unsigned vn[2][2], wn_[2][2];
#pragma unroll
    for (int h = 0; h < 2; ++h) { vn[h][0] = vc[h][0]; vn[h][1] = vc[h][1]; wn_[h][0] = wc_[h][0]; wn_[h][1] = wc_[h][1]; }
    for (;;) {
        const bool has_next = S.next(ui + 1, nxt);
        const char* nA = has_next ? S.a_base(nxt) : cA; const char* nB = has_next ? S.b_base(nxt) : cB;
        if constexpr (ONE_TRIP) {
            if (has_next) { if constexpr (!Sched::A_INV) S.a_offs(nxt, sR, sC, vn); if constexpr (!Sched::B_INV) S.b_offs(nxt, sR, sC, wn_); }
            PG8_TRIP(cA + kA, nA, nA + kA, nB, nB + kB, vc[1][0], vc[1][1], vn[0][0], vn[0][1], vn[1][0], vn[1][1], wn_[0][0], wn_[0][1], wn_[1][0], wn_[1][1]);
        } else {
            for (int t = 0; t < nt; t += 2) {
                const bool last = (t == nt - 2);
                if (last && has_next) { if constexpr (!Sched::A_INV) S.a_offs(nxt, sR, sC, vn); if constexpr (!Sched::B_INV) S.b_offs(nxt, sR, sC, wn_); }
                const char* a1 = cA + (size_t)(t + 1) * kA;
                const char* a2 = last ? nA : cA + (size_t)(t + 2) * kA; const char* b2 = last ? nB : cB + (size_t)(t + 2) * kB;
                const char* a3 = a2 + kA; const char* b3 = b2 + kB;
                const bool la = last && !Sched::A_INV, lb = last && !Sched::B_INV;
                const unsigned x00 = la ? vn[0][0] : vc[0][0], x01 = la ? vn[0][1] : vc[0][1], x10 = la ? vn[1][0] : vc[1][0], x11 = la ? vn[1][1] : vc[1][1];
                const unsigned y00 = lb ? wn_[0][0] : wc_[0][0], y01 = lb ? wn_[0][1] : wc_[0][1], y10 = lb ? wn_[1][0] : wc_[1][0], y11 = lb ? wn_[1][1] : wc_[1][1];
                PG8_TRIP(a1, a2, a3, b2, b3, vc[1][0], vc[1][1], x00, x01, x10, x11, y00, y01, y10, y11);
            }
        }
#pragma unroll
        for (int h = 0; h < 2; ++h) { vc[h][0] = vn[h][0]; vc[h][1] = vn[h][1]; wc_[h][0] = wn_[h][0]; wc_[h][1] = wn_[h][1]; }
        if (wr == 0) PG8_BAR;
        E(acc, cur, wr, wc, fr, fq);
        if (!has_next) break;
#pragma unroll
        for (int a = 0; a < 2; ++a)
#pragma unroll
            for (int b = 0; b < 2; ++b)
#pragma unroll
                for (int m = 0; m < 4; ++m)
#pragma unroll
                    for (int n = 0; n < 2; ++n) acc[a][b][m][n] = (f32x4){0.f, 0.f, 0.f, 0.f};
        cur = nxt; cA = nA; cB = nB; ++ui;
        if (wr == 1) PG8_BAR;
    }
    PG8_WAIT_V(0);
    PG8_BAR;
#undef PG8_SA
#undef PG8_SB
#undef PG8_GLDS
#undef PG8_STAGE
#undef PG8_TRIP
#undef PG8_LDA
#undef PG8_LDB
#undef PG8_MMA
#undef PG8_MMAQ
#undef PG8_WAIT_V
#undef PG8_WAIT_L
#undef PG8_BAR
#undef PG8_SCHED
}
}

struct Args { const float* in[18]; float* out; unsigned char* ws; int ph_lo, ph_hi, rep, pad; };

__device__ __forceinline__ void p0_adaln(const Args& a, LAS unsigned char* lds, float* mod) {
    const int tid = threadIdx.x;
    LAS float* sc = (LAS float*)lds;
    LAS float* red = (LAS float*)(lds + 16384);
    const float* c = a.in[1]; const float* ada_w = a.in[3]; const float* ada_b = a.in[4];
    for (int i = tid; i < 4096; i += NTHR) { const float v = c[i]; sc[i] = v / (1.f + expf(-v)); }
    __syncthreads();
    const int r = tid / 24, c4 = tid % 24;
    for (int cg = blockIdx.x; cg < 256; cg += gridDim.x) {
        const int idx = cg >> 6, col0 = (cg & 63) * 96;
        const float* W = ada_w + (size_t)idx * 2048 * 6144 + col0 + c4 * 4;
        f32x4 a0 = {0.f, 0.f, 0.f, 0.f}, a1 = {0.f, 0.f, 0.f, 0.f};
        if (tid < 504) {
            int k = r;
            for (; k + 63 < 2048; k += 84) {
                const f32x4 w0 = __builtin_nontemporal_load((const f32x4*)(W + (size_t)k * 6144)), w1 = __builtin_nontemporal_load((const f32x4*)(W + (size_t)(k + 21) * 6144)), w2 = __builtin_nontemporal_load((const f32x4*)(W + (size_t)(k + 42) * 6144)), w3 = __builtin_nontemporal_load((const f32x4*)(W + (size_t)(k + 63) * 6144));
                a0 += sc[k] * w0; a1 += sc[2048 + k] * w0; a0 += sc[k + 21] * w1; a1 += sc[2048 + k + 21] * w1;
                a0 += sc[k + 42] * w2; a1 += sc[2048 + k + 42] * w2; a0 += sc[k + 63] * w3; a1 += sc[2048 + k + 63] * w3;
            }
            for (; k < 2048; k += 21) { const f32x4 w0 = *(const f32x4*)(W + (size_t)k * 6144); a0 += sc[k] * w0; a1 += sc[2048 + k] * w0; }
            *(LAS f32x4*)(red + (r * 24 + c4) * 8) = a0; *(LAS f32x4*)(red + (r * 24 + c4) * 8 + 4) = a1;
        }
        __syncthreads();
        if (tid < 192) {
            const int cc4 = tid >> 3, j = tid & 7; float s = 0.f;
            for (int rr = 0; rr < 21; ++rr) s += red[(rr * 24 + cc4) * 8 + j];
            const int b = j >> 2, col = col0 + cc4 * 4 + (j & 3);
            mod[(idx * 2 + b) * 6144 + col] = s + ada_b[idx * 6144 + col];
        }
        __syncthreads();
    }
}

struct TJob { const float* src; bf16_t* dst; int K, N, rowmode, k0, n0; };
__device__ __forceinline__ TJob p0_job(const Args& a, int t) {
    unsigned char* ws = a.ws; TJob j; int tk, tn;
    if (t < 4608) { j = TJob{a.in[5], (bf16_t*)(ws + WS_WQKV), 2048, 18432, 0, 0, 0}; tk = t / 288; tn = t % 288; }
    else if (t < 6144) { const int q = t - 4608, w = q / 512, r = q % 512; j = TJob{a.in[6 + w], (bf16_t*)(ws + WS_WO + (size_t)w * 8 * MB), 2048, 2048, 0, 0, 0}; tk = r / 32; tn = r % 32; }
    else if (t < 22528) { const int q = t - 6144, up = q / 8192, r = q % 8192, mat = r / 128, rr = r % 128;
        j = TJob{a.in[15 + up] + (size_t)mat * 2048 * 512, (bf16_t*)(ws + WS_WGU) + (size_t)mat * 1024 * 2048, 2048, 512, 1 + up, 0, 0}; tk = rr / 8; tn = rr % 8; }
    else { const int r = t - 22528, mat = r / 128, rr = r % 128; j = TJob{a.in[17] + (size_t)mat * 512 * 2048, (bf16_t*)(ws + WS_WD) + (size_t)mat * 2048 * 512, 512, 2048, 0, 0, 0}; tk = rr / 32; tn = rr % 32; }
    j.k0 = tk * 128; j.n0 = tn * 64; return j;
}
__device__ __forceinline__ void p0_tile_load(const TJob& j, int tid, f32x4 (&f)[2][2]) {
#pragma unroll
    for (int i = 0; i < 2; ++i) { const int p = i * 32 + (tid >> 4), c = (tid & 15) * 4;
        f[i][0] = __builtin_nontemporal_load((const f32x4*)(j.src + (size_t)(j.k0 + 2 * p) * j.N + j.n0 + c)); f[i][1] = __builtin_nontemporal_load((const f32x4*)(j.src + (size_t)(j.k0 + 2 * p + 1) * j.N + j.n0 + c)); }
}
__device__ __forceinline__ int p0_tile_id(int mode, int v) { if (mode == 0) return v; const int l = mode - 1; return v < 4096 ? 6144 + l * 4096 + v : (v < 8192 ? 14336 + l * 4096 + (v - 4096) : 22528 + l * 4096 + (v - 8192)); }
__device__ __forceinline__ void p0_transposes(const Args& a, LAS unsigned char* lds, const int mode) {
    const int tid = threadIdx.x; LAS unsigned* T2 = (LAS unsigned*)lds;
    const int nv = mode == 0 ? 6144 : 12288;
    int v = blockIdx.x; if (v >= nv) return;
    int t = p0_tile_id(mode, v);
    TJob j = p0_job(a, t); f32x4 f[2][2];
    p0_tile_load(j, tid, f);
    for (;;) {
        __syncthreads();
#pragma unroll
        for (int i = 0; i < 2; ++i) { const int p = i * 32 + (tid >> 4), c = (tid & 15) * 4;
#pragma unroll
            for (int e = 0; e < 4; ++e) T2[p * 65 + c + e] = pack_bf16(f[i][0][e], f[i][1][e]); }
        const TJob cur = j; const int vn = v + gridDim.x; const bool more = vn < nv; const int tn = p0_tile_id(mode, more ? vn : v);
        if (more) { j = p0_job(a, tn); p0_tile_load(j, tid, f); }
        __syncthreads();
        const int n = tid >> 3, x = tid & 7;
        unsigned d[8];
#pragma unroll
        for (int jj = 0; jj < 8; ++jj) d[jj] = T2[(8 * x + jj) * 65 + n];
        const int nn = cur.n0 + n;
        const int row = cur.rowmode == 0 ? nn : ((nn >> 4) * 32 + (nn & 15) + (cur.rowmode == 2 ? 16 : 0));
        bf16_t* dp = cur.dst + (size_t)row * cur.K + cur.k0 + 16 * x;
        *(u32x4*)dp = (u32x4){d[0], d[1], d[2], d[3]}; *(u32x4*)(dp + 8) = (u32x4){d[4], d[5], d[6], d[7]};
        if (!more) break;
        v = vn; t = tn;
    }
    __syncthreads();
}
__device__ __forceinline__ void p0_tables(const Args& a, float* rot) {
    const int* pos = (const int*)a.in[2];
    for (int i = blockIdx.x * NTHR + threadIdx.x; i < T * 16; i += gridDim.x * NTHR) {
        const int t = i >> 4, j = i & 15;
        const float invf = (float)pow(500000.0, -(double)j / 16.0);
        const float ang = (float)pos[t] * invf;
        double r = (double)ang * 0.31830988618379067154; r -= 2.0 * rint(r * 0.5);
        float s, c; sincospif((float)r, &s, &c);
        rot[t * 32 + j] = c; rot[t * 32 + 16 + j] = s;
    }
}
__device__ __forceinline__ void p_modulate(const float* __restrict__ x, const float* __restrict__ mod, bf16_t* __restrict__ h) {
    for (size_t i = (size_t)blockIdx.x * NTHR + threadIdx.x; i < (size_t)T * D / 8; i += (size_t)gridDim.x * NTHR) {
        const size_t e = i * 8; const int t = (int)(e >> 11), d = (int)(e & 2047), b = t >> 12;
        const f32x4 x0 = *(const f32x4*)(x + e), x1 = *(const f32x4*)(x + e + 4);
        const float* m = mod + b * 6144 + d;
        const f32x4 sh0 = *(const f32x4*)m, sh1 = *(const f32x4*)(m + 4), sc0 = *(const f32x4*)(m + 2048), sc1 = *(const f32x4*)(m + 2052);
        const f32x4 y0 = x0 * (1.f + sc0) + sh0, y1 = x1 * (1.f + sc1) + sh1;
        *(u32x4*)(h + e) = (u32x4){pack_bf16(y0[0], y0[1]), pack_bf16(y0[2], y0[3]), pack_bf16(y1[0], y1[1]), pack_bf16(y1[2], y1[3])};
    }
}
struct QkvSched {
    static constexpr bool A_INV = true, B_INV = false;
    const unsigned char* ws; int G, c;
    __device__ static void grid_map(int wgid, int nM, int nN, int& pm, int& pn) {
        const int nwg = nM * nN; { const int q = nwg / pg8::NXCD, r = nwg % pg8::NXCD, xcd = wgid % pg8::NXCD, off = wgid / pg8::NXCD; wgid = (xcd < r ? xcd * (q + 1) : r * (q + 1) + (xcd - r) * q) + off; }
        const int nig = pg8::WGM * nN, gid = wgid / nig, fm = gid * pg8::WGM, gsz = (nM - fm) < pg8::WGM ? (nM - fm) : pg8::WGM;
        pm = fm + ((wgid % nig) % gsz); pn = (wgid % nig) / gsz;
    }
    __device__ bool next(int i, pg8::Unit& u) const {
        const int L = i * G + c; if (L >= 2304) return false;
        if (L < 1536) { grid_map(L, 32, 48, u.pm, u.pn); u.e = 0; const int g = u.pn >> 4, which = (u.pn >> 3) & 1; u.row0 = g * 6144 + which * 2048 + (u.pn & 7) * 256; }
        else { grid_map(L - 1536, 24, 32, u.pm, u.pn); u.e = 1; const int g = u.pm >> 3; u.row0 = g * 6144 + 4096 + (u.pm & 7) * 256; }
        u.mask = 15; return true;
    }
    __device__ __forceinline__ const char* a_base(const pg8::Unit& u) const { return (const char*)ws + (u.e == 0 ? WS_H + (size_t)u.pm * 256 * 2048 * 2 : WS_WQKV + (size_t)u.row0 * 2048 * 2); }
    __device__ __forceinline__ const char* b_base(const pg8::Unit& u) const { return (const char*)ws + (u.e == 0 ? WS_WQKV + (size_t)u.row0 * 2048 * 2 : WS_H); }
    __device__ __forceinline__ void a_offs(const pg8::Unit&, const int (&R)[2], const int (&C)[2], unsigned (&o)[2][2]) const {
#pragma unroll
        for (int h = 0; h < 2; ++h)
#pragma unroll
            for (int i = 0; i < 2; ++i) o[h][i] = (unsigned)((h * 128 + R[i]) * 2048 + C[i]) * 2u; }
    __device__ __forceinline__ void b_offs(const pg8::Unit& u, const int (&R)[2], const int (&C)[2], unsigned (&o)[2][2]) const {
        const int sh = (u.pm >> 3) * 2;
#pragma unroll
        for (int h = 0; h < 2; ++h)
#pragma unroll
            for (int i = 0; i < 2; ++i) {
                if (u.e == 0) o[h][i] = (unsigned)((h * 128 + R[i]) * 2048 + C[i]) * 2u;
                else { const int n = (u.pn & 15) * 256 + h * 128 + (R[i] & ~31) + pg8::perm32(R[i] & 31);
                    const int lg = 12 - sh, r = n >> lg, j = n & ((1 << lg) - 1), t = (u.pn >> 4) * 4096 + r + (j << sh); o[h][i] = (unsigned)(t * 2048 + C[i]) * 2u; }
            } }
    __device__ __forceinline__ unsigned kstepA() const { return 128u; }
    __device__ __forceinline__ unsigned kstepB() const { return 128u; }
};
struct EpiQKV {
    bf16_t* Qf; bf16_t* Kf; bf16_t* Vf; const float* rot;
    __device__ __forceinline__ void operator()(const f32x4 (&acc)[2][2][4][2], const pg8::Unit& u, int wr, int wc, int fr_, int fq_) const {
        int fr = fr_, fq = fq_; asm volatile("" : "+v"(fr), "+v"(fq));
        if (u.e == 0) {
            const int g = u.pn >> 4, which = (u.pn >> 3) & 1, head0 = (u.pn & 7) * 2, sh = g * 2, nbr = 128 >> sh;
            bf16_t* dst = Qf + (size_t)which * ((WS_KF - WS_QF) / 2);
#pragma unroll
            for (int ai = 0; ai < 2; ++ai)
#pragma unroll
                for (int m = 0; m < 4; ++m) {
                    const int row = u.pm * 256 + ai * 128 + wr * 64 + m * 16 + fr, b = row >> 12, s = row & 4095;
                    const int r = s & ((1 << sh) - 1), j = s >> sh, jo = j & 31, blk = r * nbr + (j >> 5);
                    f32x4 cs = {1.f, 1.f, 1.f, 1.f}, sn = {0.f, 0.f, 0.f, 0.f};
                    if (wc == 0) { const float* rp = rot + (size_t)row * 32 + 4 * fq; cs = *(const f32x4*)rp; sn = *(const f32x4*)(rp + 16); }
                    const int c = 4 * wc + fq, ks = c >> 1, hh = c & 1, lanepos = which == 0 ? jo : pi32(jo);
#pragma unroll
                    for (int bj = 0; bj < 2; ++bj) {
                        const size_t blkid = (size_t)(((g * 2 + b) * 16 + head0 + bj) * 128 + blk);
                        f32x4 v0 = acc[ai][bj][m][0], v1 = acc[ai][bj][m][1];
                        if (wc == 0) { const f32x4 t0 = v0 * cs - v1 * sn, t1 = v1 * cs + v0 * sn; v0 = t0; v1 = t1; }
                        if (which == 0) { v0 *= QSCALE; v1 *= QSCALE; }
                        *(u32x4*)(dst + ((blkid * 8 + ks) * 64 + hh * 32 + lanepos) * 8) = (u32x4){pack_bf16(v0[0], v0[1]), pack_bf16(v0[2], v0[3]), pack_bf16(v1[0], v1[1]), pack_bf16(v1[2], v1[3])};
                    }
                }
        } else {
            const int g = u.pm >> 3, sh = g * 2, nbr = 128 >> sh, lg = 12 - sh, b = u.pn >> 4;
#pragma unroll
            for (int bj = 0; bj < 2; ++bj) {
                const int n0 = (u.pn & 15) * 256 + bj * 128 + wc * 32 + 8 * fq, r = n0 >> lg, j0 = n0 & ((1 << lg) - 1), jo = j0 & 31, blk = r * nbr + (j0 >> 5);
#pragma unroll
                for (int ai = 0; ai < 2; ++ai)
#pragma unroll
                    for (int m = 0; m < 4; ++m) {
                        const int f = (u.pm & 7) * 256 + ai * 128 + wr * 64 + m * 16 + fr, head = f >> 7, d = f & 127;
                        const size_t blkid = (size_t)(((g * 2 + b) * 16 + head) * 128 + blk);
                        const f32x4 v0 = acc[ai][bj][m][0], v1 = acc[ai][bj][m][1];
                        *(u32x4*)(Vf + ((blkid * 8 + (d >> 5) * 2 + (jo >> 4)) * 64 + ((jo >> 3) & 1) * 32 + (d & 31)) * 8) = (u32x4){pack_bf16(v0[0], v0[1]), pack_bf16(v0[2], v0[3]), pack_bf16(v1[0], v1[1]), pack_bf16(v1[2], v1[3])};
                    }
            }
        }
    }
};

__device__ __forceinline__ void attn_load(const bf16_t* __restrict__ F, const size_t kblk, const int lane, bf16x8 (&f)[8]) {
    unsigned lo8 = 8u * (unsigned)lane; asm volatile("" : "+v"(lo8));
    const bf16_t* p = F + kblk * 4096;
#pragma unroll
    for (int ks = 0; ks < 8; ++ks) f[ks] = *(const bf16x8*)(p + ks * 512 + lo8);
}
__device__ __forceinline__ void attn_block(const int rel  , const bool more, const int qo, const int hh, const bf16x8 (&qf)[8], bf16x8 (&kf)[8], const bf16_t* __restrict__ Kf, const bf16_t* __restrict__ Vf, const size_t kblk, const int lane, f32x16 (&O)[4], float& m, float& l) {
    bf16x8 vf[8]; attn_load(Vf, kblk, lane, vf);
    f32x16 S;
#pragma unroll
    for (int e = 0; e < 16; ++e) S[e] = 0.f;
#pragma unroll
    for (int ks = 0; ks < 8; ++ks) S = __builtin_amdgcn_mfma_f32_32x32x16_bf16(kf[ks], qf[ks], S, 0, 0, 0);
    if (more) attn_load(Kf, kblk + 1, lane, kf);
    if (rel == -2) {
#pragma unroll
        for (int e = 0; e < 16; ++e) { const int ko = 16 * (e >> 3) + 8 * hh + (e & 7); if (ko < qo) S[e] = -1e30f; }
    }
    if (rel == 2) {
#pragma unroll
        for (int e = 0; e < 16; ++e) { const int ko = 16 * (e >> 3) + 8 * hh + (e & 7); if (ko > qo) S[e] = -1e30f; }
    }
    float bm = S[0];
#pragma unroll
    for (int e = 1; e < 16; ++e) bm = fmaxf(bm, S[e]);
    bm = fmaxf(bm, __shfl_xor(bm, 32));
    const float mn = fmaxf(m, bm), alpha = exp2f(m - mn);
    float ls = 0.f;
#pragma unroll
    for (int e = 0; e < 16; ++e) { S[e] = exp2f(S[e] - mn); ls += S[e]; }
    l = l * alpha + ls; m = mn;
#pragma unroll
    for (int db = 0; db < 4; ++db)
#pragma unroll
        for (int e = 0; e < 16; ++e) O[db][e] *= alpha;
    bf16x8 pf[2];
#pragma unroll
    for (int s2 = 0; s2 < 2; ++s2) { u32x4 w = {pack_bf16(S[8 * s2], S[8 * s2 + 1]), pack_bf16(S[8 * s2 + 2], S[8 * s2 + 3]), pack_bf16(S[8 * s2 + 4], S[8 * s2 + 5]), pack_bf16(S[8 * s2 + 6], S[8 * s2 + 7])};
        pf[s2] = __builtin_bit_cast(bf16x8, w); }
#pragma unroll
    for (int db = 0; db < 4; ++db)
#pragma unroll
        for (int s2 = 0; s2 < 2; ++s2) O[db] = __builtin_amdgcn_mfma_f32_32x32x16_bf16(vf[db * 2 + s2], pf[s2], O[db], 0, 0, 0);
}
constexpr int ATT_ROWB = 264;
__device__ __forceinline__ void p_attention(LAS unsigned char* lds, const bf16_t* __restrict__ Qf, const bf16_t* __restrict__ Kf, const bf16_t* __restrict__ Vf, bf16_t* __restrict__ o) {
    const int tid = threadIdx.x, lane = tid & 63, wave = __builtin_amdgcn_readfirstlane(tid >> 6);
    const int qo = lane & 31, hh = lane >> 5;
    LAS unsigned char* osh = lds; LAS float* lsh = (LAS float*)(lds + 512 * ATT_ROWB);
    const int vb = (gridDim.x & 7) ? (int)blockIdx.x : (int)(blockIdx.x & 7) * (int)(gridDim.x >> 3) + (int)(blockIdx.x >> 3);
    for (int unit = vb; unit < 256; unit += gridDim.x) {
        const int b = unit >> 7, head = (unit >> 3) & 15, span = unit & 7;
#pragma unroll 1
        for (int g = 0; g < 3; ++g) {
            const int sh = g * 2, nbr = 128 >> sh, nper = 16 >> sh;
            const size_t base = (size_t)(((g * 2 + b) * 16 + head) * 128);
#pragma unroll 1
            for (int rep = 0; rep < 2; ++rep) {
                const int it = wave + 8 * rep, r = it / nper, jb = span * nper + it % nper, blk = r * nbr + jb;
                const int lo = jb - 2 < 0 ? 0 : jb - 2, hi = jb + 2 > nbr - 1 ? nbr - 1 : jb + 2;
                const size_t kb0 = base + r * nbr;
                bf16x8 kf[8];
                attn_load(Kf, kb0 + lo, lane, kf);
                bf16x8 qf[8];
                attn_load(Qf, base + blk, lane, qf);
                f32x16 O[4];
#pragma unroll
                for (int db = 0; db < 4; ++db)
#pragma unroll
                    for (int e = 0; e < 16; ++e) O[db][e] = 0.f;
                float m = -1e30f, l = 0.f;
                for (int kb = lo; kb <= hi; ++kb) attn_block(kb - jb, kb < hi, qo, hh, qf, kf, Kf, Vf, kb0 + kb, lane, O, m, l);
                const float lt = l + __shfl_xor(l, 32), lse2 = m + log2f(lt);
                const int tl = r + ((32 * jb + qo) << sh) - span * 512;
                LAS unsigned char* rowp = osh + tl * ATT_ROWB + 8 * hh;
                float a0 = 0.f, a1 = 1.f / lt;
                if (g != 0) { const float lold = lsh[tl], m2 = fmaxf(lold, lse2), w0 = exp2f(lold - m2), w1 = exp2f(lse2 - m2), inv2 = 1.f / (w0 + w1);
                    a0 = w0 * inv2; a1 *= w1 * inv2; if (hh == 0) lsh[tl] = m2 + log2f(w0 + w1); }
                else if (hh == 0) lsh[tl] = lse2;
#pragma unroll
                for (int db = 0; db < 4; ++db)
#pragma unroll
                    for (int q4 = 0; q4 < 4; ++q4) {
                        LAS u32x2* p = (LAS u32x2*)(rowp + 64 * db + 16 * q4);
                        float v0 = O[db][4 * q4] * a1, v1 = O[db][4 * q4 + 1] * a1, v2 = O[db][4 * q4 + 2] * a1, v3 = O[db][4 * q4 + 3] * a1;
                        if (g != 0) { const u32x2 old = *p; v0 += a0 * __uint_as_float(old[0] << 16); v1 += a0 * __uint_as_float(old[0] & 0xffff0000u); v2 += a0 * __uint_as_float(old[1] << 16); v3 += a0 * __uint_as_float(old[1] & 0xffff0000u); }
                        *p = (u32x2){pack_bf16(v0, v1), pack_bf16(v2, v3)};
                    }
            }
            __syncthreads();
        }
        bf16_t* ob = o + ((size_t)(b * SEQ + span * 512)) * D + head * 128;
#pragma unroll 4
        for (int i2 = 0; i2 < 32; ++i2) { const int row = i2 * 16 + (tid >> 5), c = tid & 31;
            *(u32x2*)(ob + (size_t)row * D + c * 4) = *(const LAS u32x2*)(osh + row * ATT_ROWB + c * 8); }
        __syncthreads();
    }
}

constexpr size_t WS_Y = WS_QF;
constexpr size_t WS_ACT = WS_Y + 32 * MB;
constexpr size_t WS_YB = WS_ACT + 24 * MB;
constexpr size_t WS_U = WS_YB + 64 * MB;
constexpr size_t WS_ABT = WS_U + 32 * MB;
constexpr size_t WS_YF = WS_ABT + 64 * MB;
constexpr size_t WS_X1 = WS_FAST_END;
constexpr size_t WS_X2 = WS_X1 + 64 * MB;
constexpr size_t WS_T2 = WS_YF + 32 * MB;
constexpr size_t WS_D12 = WS_X2 + 64 * MB;
constexpr size_t WS_END2 = WS_D12 + 5 * MB;
static_assert(WS_T2 + 64 * MB <= WS_FAST_END, "overlay");
constexpr int LDS_TB = LDS_MISC + 64;

struct EpiBf16 {
    bf16_t* O; int ldc; float scale; int mode;
    __device__ __forceinline__ void operator()(const f32x4 (&acc)[2][2][4][2], const pg8::Unit& u, int wr, int wc, int fr, int fq) const {
        bf16_t* base = O + (mode == 1 ? (size_t)u.e * 1024 * 4096 : (size_t)0);
        const int row0 = u.pm * 256 + wr * 64 + fr, col0 = u.pn * 256 + wc * 32 + 8 * fq;
#pragma unroll
        for (int ai = 0; ai < 2; ++ai)
#pragma unroll
            for (int m = 0; m < 4; ++m) { bf16_t* rowp = base + (size_t)(row0 + ai * 128 + m * 16) * ldc + col0;
#pragma unroll
                for (int bj = 0; bj < 2; ++bj) { const f32x4 v0 = acc[ai][bj][m][0] * scale, v1 = acc[ai][bj][m][1] * scale;
                    *(u32x4*)(rowp + bj * 128) = (u32x4){pack_bf16(v0[0], v0[1]), pack_bf16(v0[2], v0[3]), pack_bf16(v1[0], v1[1]), pack_bf16(v1[2], v1[3])}; } }
    }
};

template <int NY, bool LAST>
__device__ __forceinline__ void row_ln(const int row, const int lane, const float* __restrict__ xin, const bf16_t* __restrict__ y0, const bf16_t* __restrict__ y1, const float* __restrict__ modg,
                                       const float* __restrict__ lnw, const float* __restrict__ lnb, float* __restrict__ xout, const float* __restrict__ modn, bf16_t* __restrict__ hout, f32x4 (&h)[8]) {
    const int b = row >> 12; unsigned lo4 = 4u * (unsigned)lane;
    asm volatile("" : "+v"(lo4));
    const float* xr = xin + (size_t)row * D; const bf16_t* y0r = y0 + (size_t)row * D; const bf16_t* y1r = y1 + (size_t)row * D; const float* gr = modg + b * 6144 + 4096;
    f32x4 z[8]; float sum = 0.f;
#pragma unroll
    for (int i = 0; i < 8; ++i) {
        const f32x4 xv = __builtin_nontemporal_load((const f32x4*)(xr + 256 * i + lo4)); const f32x4 gt = *(const f32x4*)(gr + 256 * i + lo4);
        const u32x2 ya = __builtin_nontemporal_load((const u32x2*)(y0r + 256 * i + lo4));
        f32x4 yv = {__uint_as_float(ya[0] << 16), __uint_as_float(ya[0] & 0xffff0000u), __uint_as_float(ya[1] << 16), __uint_as_float(ya[1] & 0xffff0000u)};
        if (NY == 2) { const u32x2 yb = __builtin_nontemporal_load((const u32x2*)(y1r + 256 * i + lo4)); yv += (f32x4){__uint_as_float(yb[0] << 16), __uint_as_float(yb[0] & 0xffff0000u), __uint_as_float(yb[1] << 16), __uint_as_float(yb[1] & 0xffff0000u)}; }
        z[i] = ALPHA * xv + gt * yv; sum += (z[i][0] + z[i][1]) + (z[i][2] + z[i][3]); }
#pragma unroll
    for (int o2 = 32; o2 >= 1; o2 >>= 1) sum += __shfl_xor(sum, o2);
    const float mean = sum * (1.f / D); float q = 0.f;
#pragma unroll
    for (int i = 0; i < 8; ++i) { const f32x4 dd = z[i] - mean; q += (dd[0] * dd[0] + dd[1] * dd[1]) + (dd[2] * dd[2] + dd[3] * dd[3]); }
#pragma unroll
    for (int o2 = 32; o2 >= 1; o2 >>= 1) q += __shfl_xor(q, o2);
    const float rstd = 1.0f / sqrtf(q * (1.f / D) + LN_EPS);
    float* xo_r = xout + (size_t)row * D; bf16_t* ho_r = hout + (size_t)row * D; const float* shr = modn + b * 6144; const float* scr = modn + b * 6144 + 2048;
#pragma unroll
    for (int i = 0; i < 8; ++i) {
        const f32x4 xo = (z[i] - mean) * rstd * *(const f32x4*)(lnw + 256 * i + lo4) + *(const f32x4*)(lnb + 256 * i + lo4);
        __builtin_nontemporal_store(xo, (f32x4*)(xo_r + 256 * i + lo4));
        if (!LAST) { const f32x4 hv = xo * (1.f + *(const f32x4*)(scr + 256 * i + lo4)) + *(const f32x4*)(shr + 256 * i + lo4);
            *(u32x2*)(ho_r + 256 * i + lo4) = (u32x2){pack_bf16(hv[0], hv[1]), pack_bf16(hv[2], hv[3])}; h[i] = hv; }
        if ((i & 3) == 3) __builtin_amdgcn_sched_barrier(0); }
}
#define LDS6(w, addr, o0) asm volatile("ds_read_b128 %0, %6 offset:%7\n\tds_read_b128 %1, %6 offset:%8\n\tds_read_b128 %2, %6 offset:%9\n\tds_read_b128 %3, %6 offset:%10\n\tds_read_b128 %4, %6 offset:%11\n\tds_read_b128 %5, %6 offset:%12\n\ts_waitcnt lgkmcnt(0)" \
    : "=&v"(w[0]), "=&v"(w[1]), "=&v"(w[2]), "=&v"(w[3]), "=&v"(w[4]), "=&v"(w[5]) : "v"(addr), "i"(o0), "i"((o0) + 2048), "i"((o0) + 4096), "i"((o0) + 6144), "i"((o0) + 8192), "i"((o0) + 10240) : "memory")
template <int Q>
__device__ __forceinline__ void router_round(LAS float* wT, const int tid, const int lane, const float* __restrict__ wr1, const float* __restrict__ wr2, const f32x4 (&h0)[8], const f32x4 (&h1)[8], float (&acc0)[36], float (&acc1)[36]) {
    __syncthreads();
#pragma unroll 1
    for (int id = tid; id < 512 * 9; id += NTHR) { const int kl = id / 9, f = id % 9, k = Q * 512 + kl;
        const f32x4 w = f == 0 ? *(const f32x4*)(wr1 + k * 4) : *(const f32x4*)(wr2 + k * 32 + (f - 1) * 4); const int c0 = f == 0 ? 0 : 4 * f;
        wT[(c0 + 0) * 512 + kl] = w[0]; wT[(c0 + 1) * 512 + kl] = w[1]; wT[(c0 + 2) * 512 + kl] = w[2]; wT[(c0 + 3) * 512 + kl] = w[3]; }
    __syncthreads();
    unsigned a0 = (unsigned)(size_t)wT + 16u * (unsigned)lane; asm volatile("" : "+v"(a0)); const unsigned a1 = a0 + 24u * 2048u;
#define RR_GROUP(ha, hb, base, c6, off) do { f32x4 w[6]; LDS6(w, base, off); _Pragma("unroll") for (int c = 0; c < 6; ++c) { \
        acc0[(c6) + c] += (ha[0] * w[c][0] + ha[1] * w[c][1]) + (ha[2] * w[c][2] + ha[3] * w[c][3]); acc1[(c6) + c] += (hb[0] * w[c][0] + hb[1] * w[c][1]) + (hb[2] * w[c][2] + hb[3] * w[c][3]); } \
        asm volatile("" : "+v"(acc0[(c6)]), "+v"(acc0[(c6) + 1]), "+v"(acc0[(c6) + 2]), "+v"(acc0[(c6) + 3]), "+v"(acc0[(c6) + 4]), "+v"(acc0[(c6) + 5]), \
                          "+v"(acc1[(c6)]), "+v"(acc1[(c6) + 1]), "+v"(acc1[(c6) + 2]), "+v"(acc1[(c6) + 3]), "+v"(acc1[(c6) + 4]), "+v"(acc1[(c6) + 5])); } while (0)
    { const f32x4 ha = h0[2 * Q], hb = h1[2 * Q];
      RR_GROUP(ha, hb, a0, 0, 0); RR_GROUP(ha, hb, a0, 6, 12288); RR_GROUP(ha, hb, a0, 12, 24576); RR_GROUP(ha, hb, a0, 18, 36864); RR_GROUP(ha, hb, a1, 24, 0); RR_GROUP(ha, hb, a1, 30, 12288); }
    { const f32x4 ha = h0[2 * Q + 1], hb = h1[2 * Q + 1];
      RR_GROUP(ha, hb, a0, 0, 1024); RR_GROUP(ha, hb, a0, 6, 13312); RR_GROUP(ha, hb, a0, 12, 25600); RR_GROUP(ha, hb, a0, 18, 37888); RR_GROUP(ha, hb, a1, 24, 1024); RR_GROUP(ha, hb, a1, 30, 13312); }
#undef RR_GROUP
}
template <int NLO, int NHI, int BIT>
__device__ __forceinline__ void rs_level(const float (&r)[NLO + NHI], float (&o)[NLO], const int lane) {
    const bool hi = (lane >> BIT) & 1;
#pragma unroll
    for (int c = 0; c < NLO; ++c) { const float lov = r[c], hiv = c < NHI ? r[c + NLO] : 0.f; const float send = hi ? lov : hiv; o[c] = (hi ? hiv : lov) + __shfl_xor(send, 1 << BIT); }
}
__device__ __forceinline__ void route_row(const float (&acc)[36], const int lrow, const int row, const int lane, LAS float* lg, const float* __restrict__ br1, const float* __restrict__ br2, float* __restrict__ gw, LAS int* hist, LAS int* asgE, LAS int* asgP) {
    float r18[18], r9[9], r5[5], r3[3], r2[2], r1[1];
    rs_level<18, 18, 5>(acc, r18, lane); rs_level<9, 9, 4>(r18, r9, lane); rs_level<5, 4, 3>(r9, r5, lane); rs_level<3, 2, 2>(r5, r3, lane); rs_level<2, 1, 1>(r3, r2, lane); rs_level<1, 1, 0>(r2, r1, lane);
    const int idx3 = ((lane >> 1) & 1) * 2 + (lane & 1), idx5 = ((lane >> 2) & 1) * 3 + idx3;
    const bool valid = (idx3 <= 2) && (idx5 <= (((lane >> 3) & 1) ? 3 : 4));
    const int col = ((lane >> 5) & 1) * 18 + ((lane >> 4) & 1) * 9 + ((lane >> 3) & 1) * 5 + idx5;
    if (valid) lg[col] = r1[0];
    asm volatile("s_waitcnt lgkmcnt(0)" ::: "memory");
    float lc[4]; float mx = -1e30f; int gi = 0;
#pragma unroll
    for (int j = 0; j < 4; ++j) { lc[j] = lg[j] + br1[j]; const bool gt = lc[j] > mx; mx = gt ? lc[j] : mx; gi = gt ? j : gi; }
    float den = 0.f;
#pragma unroll
    for (int j = 0; j < 4; ++j) den += expf(lc[j] - mx);
    const float pg = 1.f / den;
    float v1 = -1e30f, v2 = -1e30f; int i1 = 0, i2 = 0;
#pragma unroll
    for (int j = 0; j < 8; ++j) { const float v = lg[4 + gi * 8 + j] + br2[gi * 8 + j];
        const bool b1 = v > v1, b2 = v > v2;
        v2 = b1 ? v1 : (b2 ? v : v2); i2 = b1 ? i1 : (b2 ? j : i2); v1 = b1 ? v : v1; i1 = b1 ? j : i1; }
    const float e2 = expf(v2 - v1), g1 = pg / (1.f + e2), g2 = pg * e2 / (1.f + e2);
    if (lane == 0) { const int ea = gi * 8 + i1, eb = gi * 8 + i2;
        gw[row * 2] = g1; gw[row * 2 + 1] = g2;
        asgE[lrow * 2] = ea; asgP[lrow * 2] = __hip_atomic_fetch_add(&hist[ea], 1, __ATOMIC_RELAXED, __HIP_MEMORY_SCOPE_WORKGROUP);
        asgE[lrow * 2 + 1] = eb; asgP[lrow * 2 + 1] = __hip_atomic_fetch_add(&hist[eb], 1, __ATOMIC_RELAXED, __HIP_MEMORY_SCOPE_WORKGROUP); }
}
template <int NY, bool ROUTER, bool LAST>
__device__ __forceinline__ void p_rows(LAS unsigned char* lds, const float* __restrict__ xin, const bf16_t* __restrict__ y0, const bf16_t* __restrict__ y1, const float* __restrict__ modg,
                                       const float* __restrict__ lnw, const float* __restrict__ lnb, float* __restrict__ xout, const float* __restrict__ modn, bf16_t* __restrict__ hout,
                                       const float* __restrict__ wr1, const float* __restrict__ br1, const float* __restrict__ wr2, const float* __restrict__ br2,
                                       float* __restrict__ gw, int* __restrict__ list, unsigned* __restrict__ cnt) {
    const int tid = threadIdx.x, lane = tid & 63, wave = __builtin_amdgcn_readfirstlane(tid >> 6);
    LAS float* wT = (LAS float*)lds;
    LAS int* hist = (LAS int*)(lds + 73728);
    LAS float* lgs = (LAS float*)(lds + 73728 + 1024);
    LAS int* basee = hist + 32;
    LAS int* asgE = hist + 64;
    LAS int* asgP = hist + 128;
    for (int rb = blockIdx.x; rb < 256; rb += gridDim.x) {
        if (ROUTER) { if (tid < 32) hist[tid] = 0; __syncthreads(); }
#pragma unroll 1
        for (int p = 0; p < 2; ++p) {
            const int lrow = wave * 4 + p * 2, row = rb * 32 + lrow;
            f32x4 h0[8], h1[8];
            row_ln<NY, LAST>(row, lane, xin, y0, y1, modg, lnw, lnb, xout, modn, hout, h0);
            row_ln<NY, LAST>(row + 1, lane, xin, y0, y1, modg, lnw, lnb, xout, modn, hout, h1);
            if (ROUTER) {
                float acc0[36], acc1[36];
#pragma unroll
                for (int c = 0; c < 36; ++c) { acc0[c] = 0.f; acc1[c] = 0.f; }
                router_round<0>(wT, tid, lane, wr1, wr2, h0, h1, acc0, acc1);
                router_round<1>(wT, tid, lane, wr1, wr2, h0, h1, acc0, acc1);
                router_round<2>(wT, tid, lane, wr1, wr2, h0, h1, acc0, acc1);
                router_round<3>(wT, tid, lane, wr1, wr2, h0, h1, acc0, acc1);
                route_row(acc0, lrow, row, lane, lgs + lrow * 40, br1, br2, gw, hist, asgE, asgP);
                route_row(acc1, lrow + 1, row + 1, lane, lgs + (lrow + 1) * 40, br1, br2, gw, hist, asgE, asgP);
            }
        }
        if (ROUTER) {
            __syncthreads();
            if (tid < 32) { const int n = hist[tid]; basee[tid] = n ? (int)__hip_atomic_fetch_add(cnt + tid, (unsigned)n, __ATOMIC_RELAXED, __HIP_MEMORY_SCOPE_AGENT) : 0; }
            __syncthreads();
            if (tid < 64) { const int e = asgE[tid]; list[e * 8192 + basee[e] + asgP[tid]] = (rb * 32 + (tid >> 1)) * 2 + (tid & 1); }
            __syncthreads();
        }
    }
}

__device__ __forceinline__ void moe_setup(LAS unsigned char* lds, const unsigned* cnt) {
    LAS int* tb = (LAS int*)(lds + LDS_TB);
    if (threadIdx.x < 32) tb[33 + threadIdx.x] = (int)__hip_atomic_load(cnt + threadIdx.x, __ATOMIC_RELAXED, __HIP_MEMORY_SCOPE_AGENT);
    __syncthreads();
    if (threadIdx.x == 0) { int s = 0; for (int e = 0; e < 32; ++e) { tb[e] = s; const int n = (tb[33 + e] + 255) >> 8; for (int k = 0; k < n; ++k) tb[65 + s + k] = e; s += n; } tb[32] = s; }
    __syncthreads();
}
struct MoeSched {
    static constexpr bool A_INV = false, B_INV = true;
    LAS const int* tb; const bf16_t* A; const bf16_t* Bt; const int* list; int K, ldb, NT, ntshift, nrowsB, G, c; bool gather, perm;
    __device__ bool next(int i, pg8::Unit& u) const {
        const int U = tb[32] << ntshift, rfull = U / G, rem = U - rfull * G;
        int L, mask = 15;
        if (i < rfull) L = i * G + c;
        else { if (i > rfull || rem == 0) return false;
            const int split = rem * 4 <= G ? 4 : (rem * 2 <= G ? 2 : 1), part = c / rem; if (part >= split) return false;
            L = rfull * G + c % rem; mask = split == 4 ? (1 << part) : (split == 2 ? (part ? 10 : 5) : 15); }
        const int tm = L >> ntshift;
        const int e = tb[65 + tm];
        u.pm = tm; u.pn = L & (NT - 1); u.e = e; u.row0 = (tm - tb[e]) << 8; u.mask = mask; return true;
    }
    __device__ __forceinline__ const char* a_base(const pg8::Unit& u) const { return gather ? (const char*)A : (const char*)A + (size_t)u.pm * 256 * K * 2; }
    __device__ __forceinline__ const char* b_base(const pg8::Unit& u) const { return (const char*)Bt + ((size_t)u.e * nrowsB + (size_t)u.pn * 256) * K * 2; }
    __device__ __forceinline__ void a_offs(const pg8::Unit& u, const int (&R)[2], const int (&C)[2], unsigned (&o)[2][2]) const {
        const int cn = tb[33 + u.e];
#pragma unroll
        for (int h = 0; h < 2; ++h)
#pragma unroll
            for (int i = 0; i < 2; ++i) {
                if (gather) { const int row = u.row0 + h * 128 + R[i]; const int tok = row < cn ? (list[u.e * 8192 + row] >> 1) : 0; o[h][i] = (unsigned)(tok * K + C[i]) * 2u; }
                else o[h][i] = (unsigned)((h * 128 + R[i]) * K + C[i]) * 2u;
            }
    }
    __device__ __forceinline__ void b_offs(const pg8::Unit&, const int (&R)[2], const int (&C)[2], unsigned (&o)[2][2]) const {
#pragma unroll
        for (int h = 0; h < 2; ++h)
#pragma unroll
            for (int i = 0; i < 2; ++i) { const int Rb = perm ? ((R[i] & ~31) + pg8::perm32(R[i] & 31)) : R[i]; o[h][i] = (unsigned)((h * 128 + Rb) * K + C[i]) * 2u; }
    }
    __device__ __forceinline__ unsigned kstepA() const { return 128u; }
    __device__ __forceinline__ unsigned kstepB() const { return 128u; }
};
struct EpiAct {
    bf16_t* act;
    __device__ __forceinline__ void operator()(const f32x4 (&acc)[2][2][4][2], const pg8::Unit& u, int wr, int wc, int fr, int fq) const {
#pragma unroll
        for (int ai = 0; ai < 2; ++ai)
#pragma unroll
            for (int m = 0; m < 4; ++m) { const int arow = u.pm * 256 + ai * 128 + wr * 64 + m * 16 + fr;
#pragma unroll
                for (int bj = 0; bj < 2; ++bj) { if (!((u.mask >> (ai * 2 + bj)) & 1)) continue; const int j0 = (8 * u.pn + 4 * bj + wc) * 16 + 4 * fq; const f32x4 g = acc[ai][bj][m][0], up = acc[ai][bj][m][1]; f32x4 a;
#pragma unroll
                    for (int e = 0; e < 4; ++e) a[e] = g[e] / (1.f + __expf(-g[e])) * up[e];
                    *(u32x2*)(act + (size_t)arow * 512 + j0) = (u32x2){pack_bf16(a[0], a[1]), pack_bf16(a[2], a[3])}; } }
    }
};
struct EpiDown {
    LAS const int* tb; const int* list; const float* gw; bf16_t* yb;
    __device__ __forceinline__ void operator()(const f32x4 (&acc)[2][2][4][2], const pg8::Unit& u, int wr, int wc, int fr, int fq) const {
        const int cn = tb[33 + u.e], col0 = u.pn * 256 + wc * 32 + 8 * fq;
#pragma unroll
        for (int ai = 0; ai < 2; ++ai)
#pragma unroll
            for (int m = 0; m < 4; ++m) { const int row = u.row0 + ai * 128 + wr * 64 + m * 16 + fr;
                if (row < cn) { const int a = list[u.e * 8192 + row]; const float w = gw[a]; bf16_t* rowp = yb + (size_t)(a & 1) * T * D + (size_t)(a >> 1) * D + col0;
#pragma unroll
                    for (int bj = 0; bj < 2; ++bj) { if (!((u.mask >> (ai * 2 + bj)) & 1)) continue; const f32x4 v0 = acc[ai][bj][m][0] * w, v1 = acc[ai][bj][m][1] * w;
                        *(u32x4*)(rowp + bj * 128) = (u32x4){pack_bf16(v0[0], v0[1]), pack_bf16(v0[2], v0[3]), pack_bf16(v1[0], v1[1]), pack_bf16(v1[2], v1[3])}; } } }
    }
};

__device__ __forceinline__ void p0_dft(LAS unsigned char* lds, bf16_t* Dc, bf16_t* D12) {
    LAS float* tab = (LAS float*)lds;
    __syncthreads();
    for (int i = threadIdx.x; i < 4096; i += NTHR) { float s, c; sincospif((float)i / 2048.0f, &s, &c); tab[i] = c; }
    __syncthreads();
    for (size_t i = (size_t)blockIdx.x * NTHR + threadIdx.x; i < (size_t)1024 * 512 / 8; i += (size_t)gridDim.x * NTHR) {
        const size_t e = i * 8; const int m = (int)(e >> 9), c0 = (int)(e & 511), cp = m >> 1, part = m & 1; unsigned w[4];
#pragma unroll
        for (int j = 0; j < 8; j += 2) { const int i0 = (((c0 + j) * cp) & 511) * 8, i1 = (((c0 + j + 1) * cp) & 511) * 8;
            const float a = part ? tab[(i0 - 1024) & 4095] : tab[i0], b = part ? tab[(i1 - 1024) & 4095] : tab[i1]; w[j >> 1] = pack_bf16(a, b); }
        *(u32x4*)(Dc + e) = (u32x4){w[0], w[1], w[2], w[3]};
    }
    for (size_t i = (size_t)blockIdx.x * NTHR + threadIdx.x; i < (size_t)65 * 256 * 128; i += (size_t)gridDim.x * NTHR) {
        const int blk = (int)(i >> 15), r = (int)(i >> 7) & 255, k = (int)i & 127, half = k >> 6, kk = k & 63; float v = 0.f;
        if (blk == 0) { if (r < 128) { const int idx = ((r & 63) * kk * 64) & 4095; const float cs = tab[idx], sn = tab[(idx - 1024) & 4095]; v = r < 64 ? (half ? -sn : cs) : (half ? -cs : -sn); } }
        else if (r < 64) { const int idx = (kk * (64 * r + (blk - 1))) & 4095; v = half ? tab[(idx - 1024) & 4095] : tab[idx]; }
        D12[i] = (bf16_t)(pack_bf16(v, v) & 0xffffu);
    }
    __syncthreads();
}
struct ChanSched {
    static constexpr bool A_INV = true, B_INV = false;
    const bf16_t* Dc; const bf16_t* u; int G, c;
    __device__ bool next(int i, pg8::Unit& un) const { const int L = i * G + c; if (L >= 512) return false; un.e = L >> 6; const int rem = L & 63; un.pm = rem & 3; un.pn = rem >> 2; un.row0 = 0; un.mask = 15; return true; }
    __device__ __forceinline__ const char* a_base(const pg8::Unit& un) const { return (const char*)Dc + (size_t)un.pm * 256 * 512 * 2; }
    __device__ __forceinline__ const char* b_base(const pg8::Unit& un) const { return (const char*)u + ((size_t)(un.e >> 2) * 4096 * 2048 + (un.e & 3) * 512) * 2; }
    __device__ __forceinline__ void a_offs(const pg8::Unit&, const int (&R)[2], const int (&C)[2], unsigned (&o)[2][2]) const {
#pragma unroll
        for (int h = 0; h < 2; ++h)
#pragma unroll
            for (int i = 0; i < 2; ++i) o[h][i] = (unsigned)((h * 128 + R[i]) * 512 + C[i]) * 2u; }
    __device__ __forceinline__ void b_offs(const pg8::Unit& un, const int (&R)[2], const int (&C)[2], unsigned (&o)[2][2]) const {
#pragma unroll
        for (int h = 0; h < 2; ++h)
#pragma unroll
            for (int i = 0; i < 2; ++i) { const int n = un.pn * 256 + h * 128 + (R[i] & ~31) + pg8::perm32(R[i] & 31), s = (n >> 6) + 64 * (n & 63); o[h][i] = (unsigned)(s * 2048 + C[i]) * 2u; } }
    __device__ __forceinline__ unsigned kstepA() const { return 128u; }
    __device__ __forceinline__ unsigned kstepB() const { return 128u; }
};
struct Fft1Sched {
    static constexpr bool A_INV = true, B_INV = false;
    const bf16_t* D1; const bf16_t* ABt; int G, c;
    __device__ bool next(int i, pg8::Unit& un) const { const int L = i * G + c; if (L >= 1024) return false; un.pm = 0; un.pn = L; un.e = 0; un.row0 = 0; un.mask = 15; return true; }
    __device__ __forceinline__ const char* a_base(const pg8::Unit&) const { return (const char*)D1; }
    __device__ __forceinline__ const char* b_base(const pg8::Unit&) const { return (const char*)ABt; }
    __device__ __forceinline__ void a_offs(const pg8::Unit&, const int (&R)[2], const int (&C)[2], unsigned (&o)[2][2]) const {
#pragma unroll
        for (int h = 0; h < 2; ++h)
#pragma unroll
            for (int i = 0; i < 2; ++i) o[h][i] = (unsigned)((h * 128 + R[i]) * 128 + C[i]) * 2u; }
    __device__ __forceinline__ void b_offs(const pg8::Unit& un, const int (&R)[2], const int (&C)[2], unsigned (&o)[2][2]) const {
#pragma unroll
        for (int h = 0; h < 2; ++h)
#pragma unroll
            for (int i = 0; i < 2; ++i) { int rr = R[i], cc = C[i]; asm volatile("" : "+v"(rr), "+v"(cc));
                const int n = un.pn * 256 + h * 128 + (rr & ~31) + pg8::perm32(rr & 31); o[h][i] = (unsigned)((n >> 6) * 8192 + (n & 63) * 64 + cc) * 2u; } }
    __device__ __forceinline__ unsigned kstepA() const { return 128u; }
    __device__ __forceinline__ unsigned kstepB() const { return 8192u; }
};
struct EpiFft1 {
    bf16_t* T2;
    __device__ __forceinline__ void operator()(const f32x4 (&acc)[2][2][4][2], const pg8::Unit& u, int wr, int wc, int fr, int fq) const {
#pragma unroll
        for (int m = 0; m < 4; ++m) { const int k2 = 16 * m + fr;
#pragma unroll
            for (int bj = 0; bj < 2; ++bj) { const int n0 = u.pn * 256 + bj * 128 + wc * 32 + 8 * fq, colg = n0 >> 6, s10 = n0 & 63;
                const f32x4 v0 = acc[0][bj][m][0], v1 = acc[0][bj][m][1];
                *(u32x4*)(T2 + ((size_t)(colg * 64 + k2) * 2 + wr) * 64 + s10) = (u32x4){pack_bf16(v0[0], v0[1]), pack_bf16(v0[2], v0[3]), pack_bf16(v1[0], v1[1]), pack_bf16(v1[2], v1[3])}; } }
    }
};
struct Fft2Sched {
    static constexpr bool A_INV = true, B_INV = false;
    const bf16_t* D2; const bf16_t* T2; int G, c;
    __device__ bool next(int i, pg8::Unit& un) const { const int L = i * G + c; if (L >= 1024) return false; un.pm = 0; un.pn = L; un.e = 0; un.row0 = 0; un.mask = 15; return true; }
    __device__ __forceinline__ const char* a_base(const pg8::Unit& un) const { return (const char*)D2 + (size_t)((un.pn >> 3) & 63) * 256 * 128 * 2; }
    __device__ __forceinline__ const char* b_base(const pg8::Unit&) const { return (const char*)T2; }
    __device__ __forceinline__ void a_offs(const pg8::Unit&, const int (&R)[2], const int (&C)[2], unsigned (&o)[2][2]) const {
#pragma unroll
        for (int h = 0; h < 2; ++h)
#pragma unroll
            for (int i = 0; i < 2; ++i) o[h][i] = (unsigned)((h * 128 + R[i]) * 128 + C[i]) * 2u; }
    __device__ __forceinline__ void b_offs(const pg8::Unit& un, const int (&R)[2], const int (&C)[2], unsigned (&o)[2][2]) const {
#pragma unroll
        for (int h = 0; h < 2; ++h)
#pragma unroll
            for (int i = 0; i < 2; ++i) { const int n = un.pn * 256 + h * 128 + (R[i] & ~31) + pg8::perm32(R[i] & 31), b = n >> 17, k2 = (n >> 11) & 63, col = n & 2047;
                o[h][i] = (unsigned)(((b * 2048 + col) * 64 + k2) * 128 + C[i]) * 2u; } }
    __device__ __forceinline__ unsigned kstepA() const { return 128u; }
    __device__ __forceinline__ unsigned kstepB() const { return 128u; }
};
struct EpiFft2 {
    bf16_t* Y; float scale;
    __device__ __forceinline__ void operator()(const f32x4 (&acc)[2][2][4][2], const pg8::Unit& u, int wr, int wc, int fr, int fq) const {
        if (wr != 0) return;
#pragma unroll
        for (int m = 0; m < 4; ++m) { const int k1 = 16 * m + fr;
#pragma unroll
            for (int bj = 0; bj < 2; ++bj) { const int n0 = u.pn * 256 + bj * 128 + wc * 32 + 8 * fq, b = n0 >> 17, k2 = (n0 >> 11) & 63, col = n0 & 2047;
                const f32x4 v0 = acc[0][bj][m][0] * scale, v1 = acc[0][bj][m][1] * scale;
                *(u32x4*)(Y + (size_t)(b * 4096 + 64 * k1 + k2) * 2048 + col) = (u32x4){pack_bf16(v0[0], v0[1]), pack_bf16(v0[2], v0[3]), pack_bf16(v1[0], v1[1]), pack_bf16(v1[2], v1[3])}; } }
    }
};

constexpr int NPHASE = 19;
#ifndef REP_MASK
#define REP_MASK 0
#endif
#define PH_BEGIN(k) _Pragma("unroll") for (int rp = 0; rp < 1 + ((REP_MASK >> (k)) & 1); ++rp) { if (rp) xcd_barrier(bar);
__global__ void __launch_bounds__(NTHR, 2) mk_fwd(Args a) {
    extern __shared__ __attribute__((aligned(16))) unsigned char lds_raw[];
    LAS unsigned char* lds = (LAS unsigned char*)lds_raw;
    unsigned char* ws = a.ws;
    volatile LAS unsigned* misc = (volatile LAS unsigned*)(lds + LDS_MISC);
    if (threadIdx.x < 4) misc[threadIdx.x] = 0u;
    __syncthreads();
    const int lo = a.ph_lo, hi = a.ph_hi;
    XcdBarrier bar; bar.bar = (unsigned*)(ws + WS_CTL) + CW_BAR; bar.x = 0; bar.st = misc;
    if (hi - lo > 1) bar = xcd_barrier_post((unsigned*)(ws + WS_CTL) + CW_BAR, misc);
#define IN(k) (lo <= (k) && (k) < hi)
#define SEAM(k) do { if (IN(k) && IN((k) + 1)) xcd_barrier(bar); } while (0)
    float* mod = (float*)(ws + WS_MOD); float* rot = (float*)(ws + WS_ROT);
    bf16_t* hbuf = (bf16_t*)(ws + WS_H); bf16_t* ybr = (bf16_t*)(ws + WS_Y); bf16_t* yb = (bf16_t*)(ws + WS_YB); bf16_t* act = (bf16_t*)(ws + WS_ACT);
    float* x1 = (float*)(ws + WS_X1); float* x2 = (float*)(ws + WS_X2); float* gw = (float*)(ws + WS_GW); int* list = (int*)(ws + WS_LIST);
    unsigned* cnt = (unsigned*)(ws + WS_CTL) + CW_CNT;
    LAS const int* tb = (LAS const int*)(lds + LDS_TB);
    const float* x = a.in[0]; const float* ln_g = a.in[9]; const float* ln_b = a.in[10];
    const int G = gridDim.x, cid = blockIdx.x;
    const int vcid = (G & 7) ? cid : (cid & 7) * (G >> 3) + (cid >> 3);

    if (IN(0)) { PH_BEGIN(0)  p0_adaln(a, lds, mod); p0_tables(a, rot); p0_dft(lds, (bf16_t*)(ws + WS_DC), (bf16_t*)(ws + WS_D12)); p0_transposes(a, lds, 0);  } }
    SEAM(0);
    if (IN(1)) { PH_BEGIN(1)  p_modulate(x, mod, hbuf);  } }
    SEAM(1);
    if (IN(2)) { PH_BEGIN(2)  QkvSched S{ws, G, cid};
        EpiQKV E{(bf16_t*)(ws + WS_QF), (bf16_t*)(ws + WS_KF), (bf16_t*)(ws + WS_VF), rot};
        pg8::gemm_phase<EpiQKV, QkvSched>(lds, D, S, E); } }
    SEAM(2);
    if (IN(3)) { PH_BEGIN(3)  p_attention(lds, (const bf16_t*)(ws + WS_QF), (const bf16_t*)(ws + WS_KF), (const bf16_t*)(ws + WS_VF), (bf16_t*)(ws + WS_O));  } }
    SEAM(3);
    if (IN(5)) { PH_BEGIN(5)  pg8::PlainSched S; S.init((const bf16_t*)(ws + WS_O), (const bf16_t*)(ws + WS_WO), T, D, D, G, cid); EpiBf16 E{ybr, D, 1.f, 0};
        pg8::gemm_phase<EpiBf16, pg8::PlainSched>(lds, D, S, E);  } }
    SEAM(5);
    if (IN(6)) { PH_BEGIN(6)  p_rows<1, true, false>(lds, x, ybr, ybr, mod, ln_g, ln_b, x1, mod + 1 * 12288, hbuf, a.in[11], a.in[12], a.in[13], a.in[14], gw, list, cnt); __syncthreads(); p0_transposes(a, lds, 1);  } }
    SEAM(6);
    if (IN(7)) { PH_BEGIN(7)  moe_setup(lds, cnt);
        MoeSched S{tb, hbuf, (const bf16_t*)(ws + WS_WGU), list, D, D, 4, 2, 1024, G, vcid, true, false}; EpiAct E{act};
        pg8::gemm_phase<EpiAct, MoeSched, false, true>(lds, D, S, E);  } }
    SEAM(7);
    if (IN(8)) { PH_BEGIN(8)  moe_setup(lds, cnt);
        MoeSched S{tb, act, (const bf16_t*)(ws + WS_WD), list, ED, ED, 8, 3, 2048, G, vcid, false, true}; EpiDown E{tb, list, gw, yb};
        pg8::gemm_phase<EpiDown, MoeSched, false, true>(lds, ED, S, E);  } }
    SEAM(8);
    if (IN(9)) { PH_BEGIN(9)  p_rows<2, false, false>(lds, x1, yb, yb + (size_t)T * D, mod + 1 * 12288, ln_g + D, ln_b + D, x2, mod + 2 * 12288, hbuf, nullptr, nullptr, nullptr, nullptr, nullptr, nullptr, nullptr);  } }
    SEAM(9);
    if (IN(10)) { PH_BEGIN(10)  pg8::PlainSched S; S.init(hbuf, (const bf16_t*)(ws + WS_WIN), T, D, D, G, cid); EpiBf16 E{(bf16_t*)(ws + WS_U), D, 1.f, 0};
        pg8::gemm_phase<EpiBf16, pg8::PlainSched>(lds, D, S, E);  } }
    SEAM(10);
    if (IN(11)) { PH_BEGIN(11)  ChanSched S{(const bf16_t*)(ws + WS_DC), (const bf16_t*)(ws + WS_U), G, vcid}; EpiBf16 E{(bf16_t*)(ws + WS_ABT), 4096, 1.f, 1};
        pg8::gemm_phase<EpiBf16, ChanSched>(lds, 512, S, E);  } }
    SEAM(11);
    if (IN(12)) { PH_BEGIN(12)  Fft1Sched S{(const bf16_t*)(ws + WS_D12), (const bf16_t*)(ws + WS_ABT), G, cid}; EpiFft1 E{(bf16_t*)(ws + WS_T2)};
        pg8::gemm_phase<EpiFft1, Fft1Sched, true>(lds, 128, S, E); } }
    SEAM(12);
    if (IN(13)) { PH_BEGIN(13)  Fft2Sched S{(const bf16_t*)(ws + WS_D12) + 256 * 128, (const bf16_t*)(ws + WS_T2), G, cid}; EpiFft2 E{(bf16_t*)(ws + WS_YF), 6.9053396600248786e-4f};
        pg8::gemm_phase<EpiFft2, Fft2Sched, true>(lds, 128, S, E); } }
    SEAM(13);
    if (IN(14)) { PH_BEGIN(14)  pg8::PlainSched S; S.init((const bf16_t*)(ws + WS_YF), (const bf16_t*)(ws + WS_WOUT), T, D, D, G, cid); EpiBf16 E{ybr, D, 1.f, 0};
        pg8::gemm_phase<EpiBf16, pg8::PlainSched>(lds, D, S, E);  } }
    SEAM(14);
    if (IN(15)) { PH_BEGIN(15)  p_rows<1, true, false>(lds, x2, ybr, ybr, mod + 2 * 12288, ln_g + 2 * D, ln_b + 2 * D, x1, mod + 3 * 12288, hbuf, a.in[11] + D * 4, a.in[12] + 4, a.in[13] + D * 32, a.in[14] + 32, gw, list, cnt + 32); __syncthreads(); p0_transposes(a, lds, 2);  } }
    SEAM(15);
    if (IN(16)) { PH_BEGIN(16)  moe_setup(lds, cnt + 32);
        MoeSched S{tb, hbuf, (const bf16_t*)(ws + WS_WGU) + (size_t)32 * 1024 * 2048, list, D, D, 4, 2, 1024, G, vcid, true, false}; EpiAct E{act};
        pg8::gemm_phase<EpiAct, MoeSched, false, true>(lds, D, S, E);  } }
    SEAM(16);
    if (IN(17)) { PH_BEGIN(17)  moe_setup(lds, cnt + 32);
        MoeSched S{tb, act, (const bf16_t*)(ws + WS_WD) + (size_t)32 * 2048 * 512, list, ED, ED, 8, 3, 2048, G, vcid, false, true}; EpiDown E{tb, list, gw, yb};
        pg8::gemm_phase<EpiDown, MoeSched, false, true>(lds, ED, S, E);  } }
    SEAM(17);
    if (IN(18)) { PH_BEGIN(18) p_rows<2, false, true>(lds, x1, yb, yb + (size_t)T * D, mod + 3 * 12288, ln_g + 3 * D, ln_b + 3 * D, a.out, nullptr, nullptr, nullptr, nullptr, nullptr, nullptr, nullptr, nullptr, nullptr); } }
#undef IN
#undef SEAM
}

}

extern "C" void kernel_launch(void* const* d_in, const int* in_sizes, int n_in, void* d_out, int out_size, void* d_ws, size_t ws_size, hipStream_t stream) {
    (void)in_sizes; (void)n_in; (void)out_size; (void)ws_size;
    static int grid = 0;
    if (!grid) { int dev = 0, cus = 0; (void)hipGetDevice(&dev); (void)hipDeviceGetAttribute(&cus, hipDeviceAttributeMultiprocessorCount, dev);
        (void)hipFuncSetAttribute((const void*)mk_fwd, hipFuncAttributeMaxDynamicSharedMemorySize, LDS_BYTES);
        grid = (cus > 0 && cus < 256) ? cus : 256; }
    (void)hipMemsetAsync((char*)d_ws + WS_CTL, 0, CTL_BYTES, stream);
    Args a{};
    for (int i = 0; i < 18; ++i) a.in[i] = (const float*)d_in[i];
    a.out = (float*)d_out; a.ws = (unsigned char*)d_ws;
    a.ph_lo = 0; a.ph_hi = NPHASE; a.rep = 0;
    hipLaunchKernelGGL(mk_fwd, dim3(grid), dim3(NTHR), LDS_BYTES, stream, a);
}
```
